# Optimizing an MI355X kernel written in HIP

```python
import jax, jax.numpy as jnp
from jax import lax
import numpy as np

D_MODEL = 1024
BATCH = 2
SEQ = 8192
DEPTH = 1

N_META = 16
HGRN_HEADS = 8
HGRN_EXPAND = 128
HGRN_FDIM = HGRN_HEADS * HGRN_EXPAND
HGRN_VDIM = D_MODEL
HGRN_HEAD_V = HGRN_VDIM // HGRN_HEADS
CONV_DIM = D_MODEL
CONV_WIDTH = 3
D_FF = 2816
FFN_CONV_WIDTH = 3
CHUNK = 64
EPS = 1e-6
IN_SIZES = (HGRN_FDIM,
            HGRN_FDIM,
            HGRN_VDIM,
            HGRN_VDIM,
            CONV_DIM,
            CONV_DIM,
            CONV_DIM,
            D_MODEL,
            D_MODEL)
IN_TOTAL = sum(IN_SIZES)

kernel_name = "hgrn2_shortconv_gated_hybrid"


def _split_points(sizes):
    pts, acc = [], 0
    for s in sizes[:-1]:
        acc += s
        pts.append(acc)
    return pts


def rmsnorm(x, w):
    xf = x.astype(jnp.float32)
    y = xf * lax.rsqrt(jnp.mean(xf * xf, axis=-1, keepdims=True) + EPS)
    return (y * w.astype(jnp.float32)).astype(x.dtype)


def causal_dwconv(x, w, b=None):
    K = w.shape[0]
    L = x.shape[1]
    xp = jnp.pad(x, ((0, 0), (K - 1, 0), (0, 0)))
    y = w[0] * xp[:, 0:L]
    for j in range(1, K):
        y = y + w[j] * xp[:, j:j + L]
    if b is not None:
        y = y + b
    return y


def layer_lower_bounds(lb_param):
    p = jax.nn.softmax(lb_param.astype(jnp.float32), axis=0)
    return jnp.cumsum(p, axis=0)[:DEPTH]


def hgrn2_chunked(q, k, v, logf):
    Bsz, H, T, DK = q.shape
    DV = v.shape[-1]
    n = T // CHUNK

    def to_chunks(a):
        return jnp.moveaxis(a.reshape(Bsz, H, n, CHUNK, a.shape[-1]), 2, 0)

    qc, kc, vc, gc = to_chunks(q), to_chunks(k), to_chunks(v), to_chunks(logf)
    causal = jnp.tril(jnp.ones((CHUNK, CHUNK), dtype=bool))[:, :, None]

    def step(S, inp):
        qb, kb, vb, gb = inp
        G = jnp.cumsum(gb, axis=-2)
        o_inter = jnp.einsum('bhtd,bhdv->bhtv', qb * jnp.exp(G), S)
        diff = G[:, :, :, None, :] - G[:, :, None, :, :]
        decay = jnp.exp(jnp.where(causal, diff, -jnp.inf))
        A = jnp.sum(qb[:, :, :, None, :] * kb[:, :, None, :, :] * decay, axis=-1)
        o = o_inter + jnp.einsum('bhts,bhsv->bhtv', A, vb)
        G_last = G[:, :, -1:, :]
        k_dec = kb * jnp.exp(G_last - G)
        S_new = jnp.exp(G_last[:, :, 0, :])[..., None] * S + jnp.einsum('bhsd,bhsv->bhdv', k_dec, vb)
        return S_new, o

    S0 = jnp.zeros((Bsz, H, DK, DV), jnp.float32)
    _, o = lax.scan(step, S0, (qc, kc, vc, gc))
    return jnp.moveaxis(o, 0, 2).reshape(Bsz, H, T, DV)


def hybrid_layer(h, lb, attn_norm_w, w_in, hgrn_norm_w, conv_w, w_out,
                 ffn_norm_w, w_up, ffn_conv_w, ffn_conv_b, w_down):
    Bsz, L, _ = h.shape
    dt = h.dtype
    u = rmsnorm(h, attn_norm_w)
    proj = u @ w_in
    q, f_raw, i_in, g_out, b_gate, c_gate, x_conv, gate_a, gate_b = jnp.split(
        proj, _split_points(IN_SIZES), axis=-1)

    q = jax.nn.silu(q.astype(jnp.float32))
    f = lb + (1.0 - lb) * jax.nn.sigmoid(f_raw.astype(jnp.float32))
    logf = jnp.log(f)
    k = 1.0 - f
    v = i_in.astype(jnp.float32)

    def heads(a):
        return jnp.transpose(a.reshape(Bsz, L, HGRN_HEADS, -1), (0, 2, 1, 3))

    pad = (-N_META) % CHUNK
    tpad = ((0, 0), (0, 0), (pad, 0), (0, 0))
    qh, kh, vh, gh = (jnp.pad(heads(a), tpad) for a in (q, k, v, logf))
    o = hgrn2_chunked(qh, kh, vh, gh)[:, :, pad:]
    o = jnp.transpose(o, (0, 2, 1, 3))
    o = rmsnorm(o, hgrn_norm_w).reshape(Bsz, L, HGRN_VDIM)
    y_a = (o * jax.nn.silu(g_out.astype(jnp.float32))).astype(dt)

    y_b = b_gate * causal_dwconv(c_gate * x_conv, conv_w)

    merged = jax.nn.sigmoid(gate_a) * y_a + jax.nn.sigmoid(gate_b) * y_b
    h = h + merged @ w_out

    u2 = rmsnorm(h, ffn_norm_w)
    a, val = jnp.split(u2 @ w_up, 2, axis=-1)
    a = causal_dwconv(a, ffn_conv_w, ffn_conv_b)
    h = h + (jax.nn.silu(a) * val) @ w_down
    return h


def setup_inputs(seed: int = 0) -> dict:
    key = jax.random.key(seed)
    ks = jax.random.split(key, 16)
    f32 = jnp.float32
    nrm = lambda k, shape, s: jax.random.normal(k, shape, f32) * s
    return {
        "x": nrm(ks[0], (BATCH, SEQ, D_MODEL), 1.0),
        "meta_tokens": nrm(ks[1], (N_META, D_MODEL), 1.0),
        "lb_param": nrm(ks[2], (DEPTH + 1, HGRN_FDIM), 0.1),
        "attn_norm_w": 1.0 + nrm(ks[3], (DEPTH, D_MODEL), 0.02),
        "w_in": nrm(ks[4], (DEPTH, D_MODEL, IN_TOTAL), D_MODEL ** -0.5),
        "hgrn_norm_w": 1.0 + nrm(ks[5], (DEPTH, HGRN_HEAD_V), 0.02),
        "conv_w": nrm(ks[6], (DEPTH, CONV_WIDTH, CONV_DIM), CONV_WIDTH ** -0.5),
        "w_out": nrm(ks[7], (DEPTH, D_MODEL, D_MODEL), D_MODEL ** -0.5),
        "ffn_norm_w": 1.0 + nrm(ks[8], (DEPTH, D_MODEL), 0.02),
        "w_up": nrm(ks[9], (DEPTH, D_MODEL, 2 * D_FF), D_MODEL ** -0.5),
        "ffn_conv_w": nrm(ks[10], (DEPTH, FFN_CONV_WIDTH, D_FF), FFN_CONV_WIDTH ** -0.5),
        "ffn_conv_b": nrm(ks[11], (DEPTH, D_FF), 0.02),
        "w_down": nrm(ks[12], (DEPTH, D_FF, D_MODEL), D_FF ** -0.5),
        "final_norm_w": 1.0 + nrm(ks[13], (D_MODEL,), 0.02),
    }


def reference(x, meta_tokens, lb_param, attn_norm_w, w_in, hgrn_norm_w, conv_w, w_out,
              ffn_norm_w, w_up, ffn_conv_w, ffn_conv_b, w_down, final_norm_w):
    Bsz = x.shape[0]
    meta = jnp.broadcast_to(meta_tokens.astype(x.dtype)[None], (Bsz, N_META, D_MODEL))
    h = jnp.concatenate([meta, x], axis=1)
    lbs = layer_lower_bounds(lb_param)
    for l in range(DEPTH):
        h = hybrid_layer(h, lbs[l], attn_norm_w[l], w_in[l], hgrn_norm_w[l], conv_w[l],
                         w_out[l], ffn_norm_w[l], w_up[l], ffn_conv_w[l], ffn_conv_b[l],
                         w_down[l])
    h = rmsnorm(h, final_norm_w)
    return h[:, N_META:]
```

```cpp
#include <hip/hip_runtime.h>
#include <cstdint>
#include <cstdio>

namespace {
constexpr int D = 1024, BATCH = 2, SEQ = 8192, NMETA = 16, M = BATCH * SEQ, MR = M + NMETA;
constexpr int NH = 8, DH = 128, DFF = 2816, NIN = 9 * D;
constexpr float EPS = 1e-6f;
typedef unsigned short bf16_t;

__device__ __forceinline__ bf16_t f2bf(float f) { unsigned u = __builtin_bit_cast(unsigned, f); return (bf16_t)((u + 0x7fffu + ((u >> 16) & 1u)) >> 16); }
__device__ __forceinline__ float bf2f(bf16_t h) { return __builtin_bit_cast(float, (unsigned)h << 16); }
__device__ __forceinline__ float sigmoidf_(float x) { return 1.f / (1.f + __expf(-x)); }
__device__ __forceinline__ float wave_sum(float v) {
#pragma unroll
    for (int o = 1; o < 64; o <<= 1) v += __shfl_xor(v, o);
    return v;
}

constexpr size_t MiB = 1u << 20;
constexpr size_t WS_RSTD1 = 0;
constexpr size_t WS_RSTD2 = 128 * 1024;
constexpr size_t WS_OMETA = 256 * 1024;
constexpr size_t WS_H1META = 384 * 1024;
constexpr size_t WS_QS = 1 * MiB, WS_V = 34 * MiB, WS_GA = 67 * MiB, WS_BG = 100 * MiB, WS_CX = 133 * MiB, WS_LOGF = 166 * MiB;
constexpr size_t WS_MERGED = WS_QS;
constexpr size_t WS_G = WS_V;

struct P {
    const float *x, *meta, *lbp, *anw, *w_in, *hnw, *cw, *w_out, *fnw, *w_up, *fcw, *fcb, *w_down, *finw;
    float* out; unsigned char* ws;
};
__device__ __forceinline__ const float* h0row(const P& p, int r) { return r < M ? p.x + (size_t)r * D : p.meta + (size_t)(r - M) * D; }
__device__ __forceinline__ int prevrow(int r, int j) {
    if (r < M) { const int t = r % SEQ; return t >= j ? r - j : M + NMETA + (t - j); }
    const int m = r - M; return m >= j ? r - j : -1;
}

__global__ void k_rstd_h0(P p) {
    const int wave = (blockIdx.x * blockDim.x + threadIdx.x) >> 6, lane = threadIdx.x & 63;
    if (wave >= MR) return;
    const float* xr = h0row(p, wave); float s = 0.f;
    for (int k = lane; k < D; k += 64) { const float v = xr[k]; s += v * v; }
    s = wave_sum(s);
    if (lane == 0) ((float*)(p.ws + WS_RSTD1))[wave] = 1.f / sqrtf(s * (1.f / D) + EPS);
}

__global__ void __launch_bounds__(256) k_gemm1(P p) {
    const int c = blockIdx.x * 256 + threadIdx.x, r0 = blockIdx.y * 4;
    const float* xr[4];
#pragma unroll
    for (int i = 0; i < 4; ++i) xr[i] = h0row(p, r0 + i);
    float acc[4][9];
#pragma unroll
    for (int i = 0; i < 4; ++i)
#pragma unroll
        for (int g = 0; g < 9; ++g) acc[i][g] = 0.f;
    for (int k = 0; k < D; ++k) {
        const float nw = p.anw[k]; float xs[4];
#pragma unroll
        for (int i = 0; i < 4; ++i) xs[i] = xr[i][k] * nw;
        const float* wr = p.w_in + (size_t)k * NIN + c;
#pragma unroll
        for (int g = 0; g < 9; ++g) { const float w = wr[g * D];
#pragma unroll
            for (int i = 0; i < 4; ++i) acc[i][g] += xs[i] * w; }
    }
    const float l0 = p.lbp[c], l1 = p.lbp[D + c];
    const float lb = 1.f / (1.f + __expf(l1 - l0));
    const float* rstd = (const float*)(p.ws + WS_RSTD1);
    bf16_t* qs = (bf16_t*)(p.ws + WS_QS); bf16_t* vb = (bf16_t*)(p.ws + WS_V); bf16_t* ga = (bf16_t*)(p.ws + WS_GA);
    bf16_t* bg = (bf16_t*)(p.ws + WS_BG); bf16_t* cx = (bf16_t*)(p.ws + WS_CX); float* logf = (float*)(p.ws + WS_LOGF);
#pragma unroll
    for (int i = 0; i < 4; ++i) {
        const int r = r0 + i; const float s = rstd[r]; const size_t o = (size_t)r * D + c;
        const float q = acc[i][0] * s, f = acc[i][1] * s, iv = acc[i][2] * s, g = acc[i][3] * s, B = acc[i][4] * s, C = acc[i][5] * s, xc = acc[i][6] * s, gA = acc[i][7] * s, gB = acc[i][8] * s;
        qs[o] = f2bf(q * sigmoidf_(q));
        logf[o] = __logf(lb + (1.f - lb) * sigmoidf_(f));
        vb[o] = f2bf(iv);
        ga[o] = f2bf(sigmoidf_(gA) * g * sigmoidf_(g));
        bg[o] = f2bf(sigmoidf_(gB) * B);
        cx[o] = f2bf(C * xc);
    }
}

__global__ void __launch_bounds__(256) k_hgrn(P p) {
    const int wave = (blockIdx.x * blockDim.x + threadIdx.x) >> 6, lane = threadIdx.x & 63;
    if (wave >= BATCH * NH * DH) return;
    const int b = wave / (NH * DH), h = (wave / DH) % NH, vc = wave % DH;
    const bf16_t* qs = (const bf16_t*)(p.ws + WS_QS); const bf16_t* vb = (const bf16_t*)(p.ws + WS_V); const float* logf = (const float*)(p.ws + WS_LOGF);
    float* ometa = (float*)(p.ws + WS_OMETA);
    float S0 = 0.f, S1 = 0.f;
    const int L = NMETA + SEQ;
    for (int t0 = 0; t0 < L; t0 += 4) {
        float lf0[4], lf1[4], q0[4], q1[4], vv[4]; int rr[4];
#pragma unroll
        for (int u = 0; u < 4; ++u) {
            const int t = t0 + u; const int r = t < NMETA ? M + t : b * SEQ + (t - NMETA); rr[u] = r;
            const size_t o = (size_t)r * D + h * DH;
            lf0[u] = logf[o + lane]; lf1[u] = logf[o + 64 + lane]; q0[u] = bf2f(qs[o + lane]); q1[u] = bf2f(qs[o + 64 + lane]); vv[u] = bf2f(vb[o + vc]);
        }
#pragma unroll
        for (int u = 0; u < 4; ++u) {
            const float f0 = __expf(lf0[u]), f1 = __expf(lf1[u]);
            S0 = f0 * S0 + (1.f - f0) * vv[u]; S1 = f1 * S1 + (1.f - f1) * vv[u];
            const float o = wave_sum(q0[u] * S0 + q1[u] * S1);
            if (lane == 0) { const int r = rr[u];
                if (r < M) p.out[(size_t)r * D + h * DH + vc] = o; else if (b == 0) ometa[(size_t)(r - M) * D + h * DH + vc] = o; }
        }
    }
}

__global__ void __launch_bounds__(256) k_merge(P p) {
    const int wave = (blockIdx.x * blockDim.x + threadIdx.x) >> 6, lane = threadIdx.x & 63;
    if (wave >= MR * NH) return;
    const int r = wave / NH, h = wave % NH;
    const float* orow = r < M ? p.out + (size_t)r * D : (const float*)(p.ws + WS_OMETA) + (size_t)(r - M) * D;
    const bf16_t* ga = (const bf16_t*)(p.ws + WS_GA); const bf16_t* bg = (const bf16_t*)(p.ws + WS_BG); const bf16_t* cx = (const bf16_t*)(p.ws + WS_CX);
    bf16_t* merged = (bf16_t*)(p.ws + WS_MERGED);
    const int c0 = h * DH + lane, c1 = c0 + 64;
    const float o0 = orow[c0], o1 = orow[c1];
    const float ss = wave_sum(o0 * o0 + o1 * o1);
    const float rs = 1.f / sqrtf(ss * (1.f / DH) + EPS);
    const int r1 = prevrow(r, 1), r2 = prevrow(r, 2);
    float res[2];
#pragma unroll
    for (int e = 0; e < 2; ++e) {
        const int c = e ? c1 : c0; const float o = e ? o1 : o0;
        const float ya = o * rs * p.hnw[c & (DH - 1)] * bf2f(ga[(size_t)r * D + c]);
        const float x0 = bf2f(cx[(size_t)r * D + c]);
        const float x1 = r1 >= 0 ? bf2f(cx[(size_t)r1 * D + c]) : 0.f;
        const float x2 = r2 >= 0 ? bf2f(cx[(size_t)r2 * D + c]) : 0.f;
        const float conv = p.cw[c] * x2 + p.cw[D + c] * x1 + p.cw[2 * D + c] * x0;
        res[e] = ya + bf2f(bg[(size_t)r * D + c]) * conv;
    }
    merged[(size_t)r * D + c0] = f2bf(res[0]); merged[(size_t)r * D + c1] = f2bf(res[1]);
}

__global__ void __launch_bounds__(256) k_gemm2(P p) {
    const int c = blockIdx.x * 256 + threadIdx.x, r0 = blockIdx.y * 4;
    const bf16_t* merged = (const bf16_t*)(p.ws + WS_MERGED);
    float acc[4] = {0.f, 0.f, 0.f, 0.f};
    for (int k = 0; k < D; ++k) { const float w = p.w_out[(size_t)k * D + c];
#pragma unroll
        for (int i = 0; i < 4; ++i) acc[i] += bf2f(merged[(size_t)(r0 + i) * D + k]) * w; }
#pragma unroll
    for (int i = 0; i < 4; ++i) { const int r = r0 + i; const float v = h0row(p, r)[c] + acc[i];
        if (r < M) p.out[(size_t)r * D + c] = v; else ((float*)(p.ws + WS_H1META))[(size_t)(r - M) * D + c] = v; }
}
__device__ __forceinline__ const float* h1row(const P& p, int r) { return r < M ? p.out + (size_t)r * D : (const float*)(p.ws + WS_H1META) + (size_t)(r - M) * D; }
__global__ void k_rstd_h1(P p) {
    const int wave = (blockIdx.x * blockDim.x + threadIdx.x) >> 6, lane = threadIdx.x & 63;
    if (wave >= MR) return;
    const float* xr = h1row(p, wave); float s = 0.f;
    for (int k = lane; k < D; k += 64) { const float v = xr[k]; s += v * v; }
    s = wave_sum(s);
    if (lane == 0) ((float*)(p.ws + WS_RSTD2))[wave] = 1.f / sqrtf(s * (1.f / D) + EPS);
}

__global__ void __launch_bounds__(256) k_gemm3(P p) {
    const int c = blockIdx.x * 256 + threadIdx.x, r0 = blockIdx.y * 4;
    const float* rstd = (const float*)(p.ws + WS_RSTD2);
    int rows[6]; rows[0] = prevrow(r0, 2); rows[1] = prevrow(r0, 1);
#pragma unroll
    for (int i = 0; i < 4; ++i) rows[2 + i] = r0 + i;
    const float* hr[6];
#pragma unroll
    for (int i = 0; i < 6; ++i) hr[i] = h1row(p, rows[i]);
    float aa[6], vv[4];
#pragma unroll
    for (int i = 0; i < 6; ++i) aa[i] = 0.f;
#pragma unroll
    for (int i = 0; i < 4; ++i) vv[i] = 0.f;
    for (int k = 0; k < D; ++k) {
        const float nw = p.fnw[k]; const float wa = p.w_up[(size_t)k * (2 * DFF) + c] * nw, wv = p.w_up[(size_t)k * (2 * DFF) + DFF + c] * nw;
#pragma unroll
        for (int i = 0; i < 6; ++i) { const float hv = hr[i][k]; aa[i] += hv * wa; if (i >= 2) vv[i - 2] += hv * wv; }
    }
#pragma unroll
    for (int i = 0; i < 6; ++i) aa[i] *= rstd[rows[i]];
    const float w0 = p.fcw[c], w1 = p.fcw[DFF + c], w2 = p.fcw[2 * DFF + c], bb = p.fcb[c];
    bf16_t* g = (bf16_t*)(p.ws + WS_G);
#pragma unroll
    for (int i = 0; i < 4; ++i) { const float a = w0 * aa[i] + w1 * aa[i + 1] + w2 * aa[i + 2] + bb; const float val = vv[i] * rstd[r0 + i];
        g[(size_t)(r0 + i) * DFF + c] = f2bf(a * sigmoidf_(a) * val); }
}

__global__ void __launch_bounds__(256) k_gemm4(P p) {
    const int c = blockIdx.x * 256 + threadIdx.x, r0 = blockIdx.y * 4;
    const bf16_t* g = (const bf16_t*)(p.ws + WS_G);
    float acc[4] = {0.f, 0.f, 0.f, 0.f};
    for (int k = 0; k < DFF; ++k) { const float w = p.w_down[(size_t)k * D + c];
#pragma unroll
        for (int i = 0; i < 4; ++i) acc[i] += bf2f(g[(size_t)(r0 + i) * DFF + k]) * w; }
#pragma unroll
    for (int i = 0; i < 4; ++i) p.out[(size_t)(r0 + i) * D + c] += acc[i];
}
__global__ void k_final(P p) {
    const int wave = (blockIdx.x * blockDim.x + threadIdx.x) >> 6, lane = threadIdx.x & 63;
    if (wave >= M) return;
    float* xr = p.out + (size_t)wave * D; float v[16]; float s = 0.f;
#pragma unroll
    for (int j = 0; j < 16; ++j) { v[j] = xr[lane + 64 * j]; s += v[j] * v[j]; }
    s = wave_sum(s); const float rs = 1.f / sqrtf(s * (1.f / D) + EPS);
#pragma unroll
    for (int j = 0; j < 16; ++j) xr[lane + 64 * j] = v[j] * rs * p.finw[lane + 64 * j];
}
}

extern "C" void kernel_launch(void* const* d_in, const int* in_sizes, int n_in, void* d_out, int out_size, void* d_ws, size_t ws_size, hipStream_t stream) {
    if (n_in != 14 || in_sizes[0] != M * D || out_size != M * D) { fprintf(stderr, "kernel_launch: unexpected shapes\n"); return; }
    P p{}; const float** f = (const float**)&p;
    for (int i = 0; i < 14; ++i) f[i] = (const float*)d_in[i];
    p.out = (float*)d_out; p.ws = (unsigned char*)d_ws;
    hipLaunchKernelGGL(k_rstd_h0, dim3((MR * 64 + 255) / 256), dim3(256), 0, stream, p);
    hipLaunchKernelGGL(k_gemm1, dim3(D / 256, MR / 4), dim3(256), 0, stream, p);
    hipLaunchKernelGGL(k_hgrn, dim3(BATCH * NH * DH * 64 / 256), dim3(256), 0, stream, p);
    hipLaunchKernelGGL(k_merge, dim3((MR * NH * 64 + 255) / 256), dim3(256), 0, stream, p);
    hipLaunchKernelGGL(k_gemm2, dim3(D / 256, MR / 4), dim3(256), 0, stream, p);
    hipLaunchKernelGGL(k_rstd_h1, dim3((MR * 64 + 255) / 256), dim3(256), 0, stream, p);
    hipLaunchKernelGGL(k_gemm3, dim3(DFF / 256, M / 4), dim3(256), 0, stream, p);
    hipLaunchKernelGGL(k_gemm4, dim3(D / 256, M / 4), dim3(256), 0, stream, p);
    hipLaunchKernelGGL(k_final, dim3((M * 64 + 255) / 256), dim3(256), 0, stream, p);
}
```

```cpp
#include <hip/hip_runtime.h>
#include <cstdint>
#include <cstdio>
namespace pg8 {
#define PG8_LAS __attribute__((address_space(3)))
typedef unsigned short bf16_t;
typedef short bf16x8 __attribute__((ext_vector_type(8)));
typedef float f32x4 __attribute__((ext_vector_type(4)));
typedef unsigned u32x4 __attribute__((ext_vector_type(4)));
constexpr int BM = 256, BK = 64, HALF = 128, HTB = HALF * BK * 2  , STAGE_BYTES = 8 * HTB, NXCD = 8, WGM = 8;

__host__ __device__ __forceinline__ int lds_byte(int r, int c) { const int st = (r >> 4) * 2 + (c >> 5), rr = r & 15, cc = c & 31, ob = rr * 64 + cc * 2; return st * 1024 + (ob ^ (((ob >> 9) & 1) << 5)); }
__host__ __device__ __forceinline__ void stage_rc(int b, int& R, int& C) { const int st = b / 1024, sb = b % 1024, swz = sb ^ (((sb >> 9) & 1) << 5); R = (st >> 1) * 16 + swz / 64; C = (st & 1) * 32 + (swz % 64) / 2; }
__host__ __device__ __forceinline__ int perm32(int rho) { const int n = rho >> 4, i = rho & 15; return 8 * (i >> 2) + 4 * n + (i & 3); }

struct Unit { int pm, pn; };
struct Gemm { const bf16_t* A; const bf16_t* Bt; int M, N, K; };

struct StaticOrder {
    int nM, nN, nwg, G, c;
    __host__ __device__ void init(int M, int N, int G_, int c_) { nM = M / BM; nN = N / BM; nwg = nM * nN; G = G_; c = c_; }
    __host__ __device__ bool next(int i, Unit& u) const {
        const long L = (long)i * G + c; if (L >= nwg) return false;
        int wgid = (int)L; { const int q = nwg / NXCD, r = nwg % NXCD, xcd = wgid % NXCD, off = wgid / NXCD; wgid = (xcd < r ? xcd * (q + 1) : r * (q + 1) + (xcd - r) * q) + off; }
        const int nig = WGM * nN, gid = wgid / nig, fm = gid * WGM, gsz = (nM - fm) < WGM ? (nM - fm) : WGM;
        u.pm = fm + ((wgid % nig) % gsz); u.pn = (wgid % nig) / gsz; return true;
    }
    __device__ __forceinline__ size_t a_off(const Unit& u, size_t tstep) const { return (size_t)u.pm * tstep; }
    __device__ __forceinline__ void a_ready(const Unit&) const {}
    __device__ __forceinline__ void done(const Unit&) const {}
};

__device__ __forceinline__ unsigned cvt_pk_bf16(float lo, float hi) { unsigned r; asm volatile("v_cvt_pk_bf16_f32 %0, %1, %2" : "=v"(r) : "v"(lo), "v"(hi)); return r; }
template <class Epi, class Sched, bool ALIGN_EPI = false, bool SP2 = false>
__device__ __forceinline__ void gemm_phase(PG8_LAS unsigned char* lds, const Gemm g, const Sched& S, const Epi& E) {
    const int tid = threadIdx.x, wid = __builtin_amdgcn_readfirstlane(tid >> 6), lane = tid & 63, wr = wid >> 2, wc = wid & 3, fr = lane & 15, fq = lane >> 4;
    const int K = g.K, nt = K / BK;
    unsigned voffA[2], voffB[2];
#pragma unroll
    for (int i = 0; i < 2; ++i) { int R, C; stage_rc(tid * 16 + i * 8192, R, C); const int Rb = Epi::PERM ? ((R & ~31) + perm32(R & 31)) : R;
        voffA[i] = (unsigned)(R * K + C) * 2u; voffB[i] = (unsigned)(Rb * K + C) * 2u; }
    const size_t kstep = (size_t)(BK * 2);
    const size_t hstep = (size_t)HALF * K * 2;
    const size_t tstep = 2 * hstep;
    const unsigned ldsw = (unsigned)wid * 1024u;
    const int aoff = lds_byte(wr * 64 + fr, fq * 8), boff = lds_byte(wc * 32 + fr, fq * 8);
#define PG8_SA(b, h) (((b) * 2 + (h)) * HTB)
#define PG8_SB(b, h) ((4 + (b) * 2 + (h)) * HTB)
#define PG8_STAGE(bufoff, gbase, voff) do { _Pragma("unroll") for (int _i = 0; _i < 2; ++_i) \
        __builtin_amdgcn_global_load_lds((const unsigned*)((const char*)(gbase) + (voff)[_i]), (PG8_LAS unsigned*)(lds + (bufoff) + ldsw + _i * 8192), 16, 0, 0); } while (0)
#define PG8_LDA(dst, b, h) do { _Pragma("unroll") for (int m = 0; m < 4; ++m) _Pragma("unroll") for (int k = 0; k < 2; ++k) dst[m][k] = *(const PG8_LAS bf16x8*)(lds + PG8_SA(b, h) + aoff + m * 2048 + k * 1024); } while (0)
#define PG8_LDB(dst, b, h) do { _Pragma("unroll") for (int n = 0; n < 2; ++n) _Pragma("unroll") for (int k = 0; k < 2; ++k) dst[n][k] = *(const PG8_LAS bf16x8*)(lds + PG8_SB(b, h) + boff + n * 2048 + k * 1024); } while (0)
#define PG8_MMA(ai, bj, At, Bt) do { __builtin_amdgcn_s_setprio(1); _Pragma("unroll") for (int m = 0; m < 4; ++m) _Pragma("unroll") for (int n = 0; n < 2; ++n) _Pragma("unroll") for (int k = 0; k < 2; ++k) \
        acc[ai][bj][m][n] = __builtin_amdgcn_mfma_f32_16x16x32_bf16(Bt[n][k], At[m][k], acc[ai][bj][m][n], 0, 0, 0); __builtin_amdgcn_s_setprio(0); } while (0)
#define PG8_WAIT_V(n) asm volatile("s_waitcnt vmcnt(" #n ")" ::: "memory")
#define PG8_WAIT_L(n) asm volatile("s_waitcnt lgkmcnt(" #n ")" ::: "memory")
#define PG8_BAR __builtin_amdgcn_s_barrier()
#define PG8_SCHED __builtin_amdgcn_sched_barrier(0)
    Unit cur, nxt; int ui = 0;
    if (!S.next(0, cur)) return;
    f32x4 acc[2][2][4][2];
#pragma unroll
    for (int a = 0; a < 2; ++a)
#pragma unroll
        for (int b = 0; b < 2; ++b)
#pragma unroll
            for (int m = 0; m < 4; ++m)
#pragma unroll
                for (int n = 0; n < 2; ++n) acc[a][b][m][n] = (f32x4){0.f, 0.f, 0.f, 0.f};
    bf16x8 At[4][2], B0[2][2], B1[2][2];
    const char* cA = (const char*)g.A + S.a_off(cur, tstep); const char* cB = (const char*)g.Bt + (size_t)cur.pn * tstep;
    S.a_ready(cur);
    if constexpr (SP2) {
        PG8_STAGE(PG8_SB(0, 0), cB, voffB); PG8_STAGE(PG8_SB(0, 1), cB + hstep, voffB); PG8_STAGE(PG8_SA(0, 0), cA, voffA); PG8_STAGE(PG8_SA(0, 1), cA + hstep, voffA);
        if (wr == 1) PG8_BAR;
        PG8_WAIT_V(2); PG8_BAR;
        PG8_STAGE(PG8_SB(1, 0), cB + kstep, voffB); PG8_STAGE(PG8_SA(1, 0), cA + kstep, voffA); PG8_STAGE(PG8_SB(1, 1), cB + hstep + kstep, voffB);
        PG8_WAIT_V(6); PG8_BAR;
    } else {
        PG8_STAGE(PG8_SB(0, 0), cB, voffB); PG8_STAGE(PG8_SA(0, 0), cA, voffA); PG8_STAGE(PG8_SB(0, 1), cB + hstep, voffB); PG8_STAGE(PG8_SA(0, 1), cA + hstep, voffA);
        if (wr == 1) PG8_BAR;
        PG8_WAIT_V(4); PG8_BAR;
        PG8_STAGE(PG8_SB(1, 0), cB + kstep, voffB); PG8_STAGE(PG8_SA(1, 0), cA + kstep, voffA); PG8_STAGE(PG8_SB(1, 1), cB + hstep + kstep, voffB);
        PG8_WAIT_V(6); PG8_BAR;
    }
    for (;;) {
        const bool has_next = S.next(ui + 1, nxt);
        const char* nA = has_next ? (const char*)g.A + S.a_off(nxt, tstep) : cA; const char* nB = has_next ? (const char*)g.Bt + (size_t)nxt.pn * tstep : cB;
        for (int t = 0; t < nt; t += 2) {
            const bool last = (t == nt - 2);
            const char* a1 = cA + (size_t)(t + 1) * kstep;
            const char* a2 = last ? nA : cA + (size_t)(t + 2) * kstep; const char* b2 = last ? nB : cB + (size_t)(t + 2) * kstep;
            const char* a3 = a2 + kstep; const char* b3 = b2 + kstep;
            if (last && has_next) S.a_ready(nxt);
            if constexpr (SP2) {
            PG8_LDB(B0, 0, 0); PG8_LDB(B1, 0, 1); PG8_SCHED; PG8_LDA(At, 0, 0); PG8_STAGE(PG8_SA(1, 1), a1 + hstep, voffA);
            PG8_WAIT_V(8); PG8_WAIT_L(0); PG8_BAR; PG8_MMA(0, 0, At, B0); PG8_MMA(0, 1, At, B1); PG8_BAR; PG8_SCHED;
            PG8_LDA(At, 0, 1); PG8_STAGE(PG8_SB(0, 0), b2, voffB); PG8_STAGE(PG8_SB(0, 1), b2 + hstep, voffB); PG8_STAGE(PG8_SA(0, 0), a2, voffA);
            PG8_WAIT_V(8); PG8_WAIT_L(0); PG8_BAR; PG8_MMA(1, 0, At, B0); PG8_MMA(1, 1, At, B1); PG8_BAR; PG8_SCHED;
            PG8_LDB(B0, 1, 0); PG8_LDB(B1, 1, 1); PG8_SCHED; PG8_LDA(At, 1, 0); PG8_STAGE(PG8_SA(0, 1), a2 + hstep, voffA);
            PG8_WAIT_V(8); PG8_WAIT_L(0); PG8_BAR; PG8_MMA(0, 0, At, B0); PG8_MMA(0, 1, At, B1); PG8_BAR; PG8_SCHED;
            PG8_LDA(At, 1, 1); PG8_STAGE(PG8_SB(1, 0), b3, voffB); PG8_STAGE(PG8_SB(1, 1), b3 + hstep, voffB); PG8_STAGE(PG8_SA(1, 0), a3, voffA);
            PG8_WAIT_V(8); PG8_WAIT_L(0); PG8_BAR; PG8_MMA(1, 0, At, B0); PG8_MMA(1, 1, At, B1); PG8_BAR; PG8_SCHED;
            } else {
            PG8_LDB(B0, 0, 0); PG8_SCHED; PG8_LDA(At, 0, 0); PG8_STAGE(PG8_SA(1, 1), a1 + hstep, voffA);
            PG8_WAIT_L(8); PG8_BAR; PG8_WAIT_L(0); PG8_MMA(0, 0, At, B0); PG8_BAR; PG8_SCHED;
            PG8_LDB(B1, 0, 1); PG8_STAGE(PG8_SB(0, 0), b2, voffB);
            PG8_BAR; PG8_WAIT_L(0); PG8_MMA(0, 1, At, B1); PG8_BAR;
            PG8_LDA(At, 0, 1); PG8_STAGE(PG8_SA(0, 0), a2, voffA);
            PG8_BAR; PG8_WAIT_L(0); PG8_MMA(1, 0, At, B0); PG8_BAR; PG8_SCHED;
            PG8_STAGE(PG8_SB(0, 1), b2 + hstep, voffB);
            PG8_WAIT_V(6); PG8_BAR; PG8_MMA(1, 1, At, B1); PG8_BAR;
            PG8_LDB(B0, 1, 0); PG8_SCHED; PG8_LDA(At, 1, 0); PG8_STAGE(PG8_SA(0, 1), a2 + hstep, voffA);
            PG8_WAIT_L(8); PG8_BAR; PG8_WAIT_L(0); PG8_MMA(0, 0, At, B0); PG8_BAR; PG8_SCHED;
            PG8_LDB(B1, 1, 1); PG8_STAGE(PG8_SB(1, 0), b3, voffB);
            PG8_BAR; PG8_WAIT_L(0); PG8_MMA(0, 1, At, B1); PG8_BAR;
            PG8_LDA(At, 1, 1); PG8_STAGE(PG8_SA(1, 0), a3, voffA);
            PG8_BAR; PG8_WAIT_L(0); PG8_MMA(1, 0, At, B0); PG8_BAR; PG8_SCHED;
            PG8_STAGE(PG8_SB(1, 1), b3 + hstep, voffB);
            PG8_WAIT_V(6); PG8_BAR; PG8_MMA(1, 1, At, B1); PG8_BAR;
            }
        }
        if constexpr (ALIGN_EPI) { if (wr == 0) PG8_BAR; }
        if constexpr (!Epi::AFTER_DRAIN) { E(acc, cur, wr, wc, fr, fq); S.done(cur); }
        if (!has_next) break;
#pragma unroll
        for (int a = 0; a < 2; ++a)
#pragma unroll
            for (int b = 0; b < 2; ++b)
#pragma unroll
                for (int m = 0; m < 4; ++m)
#pragma unroll
                    for (int n = 0; n < 2; ++n) acc[a][b][m][n] = (f32x4){0.f, 0.f, 0.f, 0.f};
        cur = nxt; cA = nA; cB = nB; ++ui;
        if constexpr (ALIGN_EPI) { if (wr == 1) PG8_BAR; }
    }
    PG8_WAIT_V(0);
    if constexpr (!ALIGN_EPI) { if (wr == 0) PG8_BAR; }
    PG8_BAR;
    if constexpr (Epi::AFTER_DRAIN) { E.fused(acc, cur, wr, wc, fr, fq, lds, wid, lane); S.done(cur); }
#undef PG8_SA
#undef PG8_SB
#undef PG8_STAGE
#undef PG8_LDA
#undef PG8_LDB
#undef PG8_MMA
#undef PG8_WAIT_V
#undef PG8_WAIT_L
#undef PG8_BAR
#undef PG8_SCHED
}
}

constexpr int NWAVES = 8;
constexpr int D = 1024, BATCH = 2, SEQ = 8192, NMETA = 16, M = BATCH * SEQ, MR = M + NMETA;
constexpr int NH = 8, DH = 128, DFF = 2816, NIN = 9 * D, NUP = 2 * DFF;
constexpr float EPS = 1e-6f;
typedef unsigned short bf16;
typedef float f32x4 __attribute__((ext_vector_type(4)));
typedef unsigned u32x4 __attribute__((ext_vector_type(4)));
typedef short bf16x8 __attribute__((ext_vector_type(8)));
#define GAS __attribute__((address_space(1)))
#define LAS __attribute__((address_space(3)))
typedef GAS unsigned gu32;
#define RLX_AGENT __ATOMIC_RELAXED, __HIP_MEMORY_SCOPE_AGENT
#define LDS_WAIT() asm volatile("s_waitcnt lgkmcnt(0)" ::: "memory")
#define VM_WAIT() asm volatile("s_waitcnt vmcnt(0)" ::: "memory")

constexpr size_t MiB = 1u << 20;
constexpr size_t WS_CTL = 0, CTL_ZERO_BYTES = 1 * MiB;
constexpr int CW_BAR = 4096;
constexpr size_t WS_RSS2 = 128 * 1024;
constexpr size_t WS_RSS3 = 256 * 1024;
constexpr size_t WS_LB = 1 * MiB;
constexpr size_t WS_LOGFM = WS_LB + 64 * 1024;
constexpr size_t WS_H1M = WS_LB + 128 * 1024;
constexpr size_t WS_RSTD2 = WS_LB + 192 * 1024;
constexpr size_t WS_WIN = 2 * MiB, WS_WOUT = 20 * MiB, WS_WUP = 22 * MiB, WS_WDN = 33 * MiB;
constexpr size_t WS_XB = 40 * MiB;
constexpr size_t WS_QS = 73 * MiB, WS_V = 106 * MiB, WS_GA = 139 * MiB, WS_BG = 172 * MiB, WS_CX = 205 * MiB;
constexpr size_t WS_O = WS_XB;
constexpr size_t WS_MERGED = WS_QS;
constexpr size_t WS_G = WS_V;
constexpr size_t WS_END = 256 * MiB;
static_assert(WS_V == WS_QS + 33 * MiB && WS_GA == WS_QS + 66 * MiB && WS_BG == WS_QS + 99 * MiB && WS_CX == WS_QS + 132 * MiB, "gate buffers are 33 MiB apart");

constexpr int RING_BYTES = 131072, LDSCTL_OFF = RING_BYTES, MISC_OFF = LDSCTL_OFF + 320, LDS_BYTES = 147456;

__device__ __forceinline__ unsigned f2bf(float f) { unsigned u = __builtin_bit_cast(unsigned, f); return (u + 0x7fffu + ((u >> 16) & 1u)) >> 16; }
__device__ __forceinline__ unsigned pk2(float lo, float hi) { return f2bf(lo) | (f2bf(hi) << 16); }
__device__ __forceinline__ float bf2f(bf16 h) { return __builtin_bit_cast(float, (unsigned)h << 16); }
__device__ __forceinline__ float sigm(float x) { return __builtin_amdgcn_rcpf(1.f + __expf(-x)); }
__device__ __forceinline__ float wave_sum(float v) {
#pragma unroll
    for (int o = 1; o < 64; o <<= 1) v += __shfl_xor(v, o);
    return v;
}

struct P {
    const float *x, *meta, *lbp, *anw, *w_in, *hnw, *cw, *w_out, *fnw, *w_up, *fcw, *fcb, *w_down, *finw;
    float* out; unsigned char* ws;
};

__device__ __forceinline__ float epi1_math(int type, float a, float b, float lb) {
    switch (type) {
        case 0: return a * sigm(a);
        case 1: return __logf(lb + (1.f - lb) * sigm(a));
        case 2: return a;
        case 3: return sigm(b) * a * sigm(a);
        case 4: return sigm(b) * a;
        default: return a * b;
    }
}
struct Epi1 {
    static constexpr bool PERM = true, AFTER_DRAIN = false;
    unsigned char* ws; float* logf; const float* lb;
    __device__ __forceinline__ void operator()(const pg8::f32x4 (&acc)[2][2][4][2], const pg8::Unit& u, int wr, int wc, int fr, int fq) const {
        const int pn = u.pn, type = pn < 12 ? (pn >> 2) : 3 + ((pn - 12) >> 3);
        const int row0 = u.pm * 256 + wr * 64 + fr;
        if (type <= 2) {
            const int cb = (pn & 3) * 256 + wc * 32 + 8 * fq;
            if (type == 1) {
                float lbv[2][8];
#pragma unroll
                for (int bj = 0; bj < 2; ++bj)
#pragma unroll
                    for (int e = 0; e < 8; ++e) lbv[bj][e] = lb[cb + bj * 128 + e];
#pragma unroll
                for (int ai = 0; ai < 2; ++ai)
#pragma unroll
                    for (int m = 0; m < 4; ++m) { float* rowp = logf + (size_t)(row0 + ai * 128 + m * 16) * D + cb;
#pragma unroll
                        for (int bj = 0; bj < 2; ++bj) { pg8::f32x4 o0, o1;
#pragma unroll
                            for (int e = 0; e < 4; ++e) { o0[e] = epi1_math(1, acc[ai][bj][m][0][e], 0.f, lbv[bj][e]); o1[e] = epi1_math(1, acc[ai][bj][m][1][e], 0.f, lbv[bj][4 + e]); }
                            *(pg8::f32x4*)(rowp + bj * 128) = o0; *(pg8::f32x4*)(rowp + bj * 128 + 4) = o1; } }
            } else {
                bf16* base = (bf16*)(ws + WS_QS + (size_t)(type == 0 ? 0 : 1) * (33 * MiB));
#pragma unroll
                for (int ai = 0; ai < 2; ++ai)
#pragma unroll
                    for (int m = 0; m < 4; ++m) { bf16* rowp = base + (size_t)(row0 + ai * 128 + m * 16) * D + cb;
#pragma unroll
                        for (int bj = 0; bj < 2; ++bj) { pg8::f32x4 v0 = acc[ai][bj][m][0], v1 = acc[ai][bj][m][1];
                            if (type == 0) {
#pragma unroll
                                for (int e = 0; e < 4; ++e) { v0[e] = epi1_math(0, v0[e], 0.f, 0.f); v1[e] = epi1_math(0, v1[e], 0.f, 0.f); } }
                            pg8::u32x4 w; w.x = pg8::cvt_pk_bf16(v0[0], v0[1]); w.y = pg8::cvt_pk_bf16(v0[2], v0[3]); w.z = pg8::cvt_pk_bf16(v1[0], v1[1]); w.w = pg8::cvt_pk_bf16(v1[2], v1[3]);
                            *(pg8::u32x4*)(rowp + bj * 128) = w; } }
            }
        } else {
            const int cb = ((pn - 12) & 7) * 128 + wc * 32 + 8 * fq;
            bf16* base = (bf16*)(ws + WS_QS + (size_t)(type - 1) * (33 * MiB));
#pragma unroll
            for (int ai = 0; ai < 2; ++ai)
#pragma unroll
                for (int m = 0; m < 4; ++m) { bf16* rowp = base + (size_t)(row0 + ai * 128 + m * 16) * D + cb;
                    const pg8::f32x4 a0 = acc[ai][0][m][0], a1 = acc[ai][0][m][1], b0 = acc[ai][1][m][0], b1 = acc[ai][1][m][1]; pg8::f32x4 v0, v1;
                    if (type == 3) {
#pragma unroll
                        for (int e = 0; e < 4; ++e) { v0[e] = epi1_math(3, a0[e], b0[e], 0.f); v1[e] = epi1_math(3, a1[e], b1[e], 0.f); }
                    } else if (type == 4) {
#pragma unroll
                        for (int e = 0; e < 4; ++e) { v0[e] = epi1_math(4, a0[e], b0[e], 0.f); v1[e] = epi1_math(4, a1[e], b1[e], 0.f); }
                    } else { v0 = a0 * b0; v1 = a1 * b1; }
                    pg8::u32x4 w; w.x = pg8::cvt_pk_bf16(v0[0], v0[1]); w.y = pg8::cvt_pk_bf16(v0[2], v0[3]); w.z = pg8::cvt_pk_bf16(v1[0], v1[1]); w.w = pg8::cvt_pk_bf16(v1[2], v1[3]);
                    *(pg8::u32x4*)rowp = w; }
        }
    }
};

__host__ __device__ __forceinline__ int win_dst_row(int n) {
    const int g = n >> 10, c = n & 1023, pr = (c >> 7) * 256 + (c & 127);
    switch (g) { case 0: case 1: case 2: return n; case 3: return 3072 + pr; case 7: return 3072 + 128 + pr; case 4: return 5120 + pr; case 8: return 5120 + 128 + pr; case 5: return 7168 + pr; default: return 7168 + 128 + pr; }
}
__host__ __device__ __forceinline__ int wup_dst_row(int n) { const int c = n < DFF ? n : n - DFF; return (c >> 7) * 256 + (c & 127) + (n < DFF ? 0 : 128); }

__device__ __forceinline__ void p0_transpose_item(const float* W, int K, int N, bf16* WT, int dst_row0, const float* kscale, LAS float* scr, int k0, int n0, int lane) {
#pragma unroll 8
    for (int i = 0; i < 32; ++i) { const int kk = 2 * i + (lane >> 5); float w = W[(size_t)(k0 + kk) * N + n0 + (lane & 31)]; if (kscale) w *= kscale[k0 + kk]; scr[kk * 33 + (lane & 31)] = w; }
    LDS_WAIT(); asm volatile("" ::: "memory");
    const int c = lane & 7;
#pragma unroll
    for (int j = 0; j < 4; ++j) { const int n = (lane >> 3) + 8 * j; const LAS float* s = scr + (8 * c) * 33 + n;
        u32x4 o; o.x = pk2(s[0 * 33], s[1 * 33]); o.y = pk2(s[2 * 33], s[3 * 33]); o.z = pk2(s[4 * 33], s[5 * 33]); o.w = pk2(s[6 * 33], s[7 * 33]);
        *(GAS u32x4*)(WT + (size_t)(dst_row0 + n) * K + k0 + 8 * c) = o; }
    LDS_WAIT(); asm volatile("" ::: "memory");
}
__device__ __forceinline__ const float* h0row(const P& p, int r) { return r < M ? p.x + (size_t)r * D : p.meta + (size_t)(r - M) * D; }
__device__ __forceinline__ void p0_prologue(const P& p, LAS unsigned char* lds, int vcu, int G, int wave, int lane) {
    LAS float* scr = (LAS float*)(lds + wave * 16384);
    const int gw = vcu * NWAVES + wave, NGW = G * NWAVES;
    constexpr int I_IN = (D / 64) * (NIN / 32), I_OUT = (D / 64) * (D / 32), I_UP = (D / 64) * (NUP / 32), I_DN = (DFF / 64) * (D / 32);
    constexpr int NITEMS = I_IN + I_OUT + I_UP + I_DN;
    bf16* win = (bf16*)(p.ws + WS_WIN); bf16* wout = (bf16*)(p.ws + WS_WOUT); bf16* wup = (bf16*)(p.ws + WS_WUP); bf16* wdn = (bf16*)(p.ws + WS_WDN);
    for (int it = gw; it < NITEMS; it += NGW) {
        int r = it;
        if (r < I_IN) { const int nblk = NIN / 32, kb = r / nblk, nb = r % nblk; p0_transpose_item(p.w_in, D, NIN, win, win_dst_row(32 * nb), p.anw, scr, 64 * kb, 32 * nb, lane); continue; } r -= I_IN;
        if (r < I_OUT) { const int nblk = D / 32, kb = r / nblk, nb = r % nblk; p0_transpose_item(p.w_out, D, D, wout, 32 * nb, nullptr, scr, 64 * kb, 32 * nb, lane); continue; } r -= I_OUT;
        if (r < I_UP) { const int nblk = NUP / 32, kb = r / nblk, nb = r % nblk; p0_transpose_item(p.w_up, D, NUP, wup, wup_dst_row(32 * nb), p.fnw, scr, 64 * kb, 32 * nb, lane); continue; } r -= I_UP;
        { const int nblk = D / 32, kb = r / nblk, nb = r % nblk; p0_transpose_item(p.w_down, DFF, D, wdn, 32 * nb, nullptr, scr, 64 * kb, 32 * nb, lane); }
    }
    bf16* xb = (bf16*)(p.ws + WS_XB);
    for (int m = gw; m < MR; m += NGW) {
        const GAS f32x4* xr = (const GAS f32x4*)h0row(p, m) + lane;
        f32x4 v[4]; float s = 0.f;
#pragma unroll
        for (int j = 0; j < 4; ++j) { v[j] = xr[64 * j]; s += (v[j].x * v[j].x + v[j].y * v[j].y) + (v[j].z * v[j].z + v[j].w * v[j].w); }
        const float rstd = 1.f / sqrtf(wave_sum(s) * (1.f / D) + EPS);
        GAS unsigned long long* o8 = (GAS unsigned long long*)(xb + (size_t)m * D) + lane;
#pragma unroll
        for (int j = 0; j < 4; ++j) o8[64 * j] = (unsigned long long)pk2(v[j].x * rstd, v[j].y * rstd) | ((unsigned long long)pk2(v[j].z * rstd, v[j].w * rstd) << 32);
    }
    if (gw < 16) { float* lb = (float*)(p.ws + WS_LB); const int c = gw * 64 + lane; lb[c] = 1.f / (1.f + __expf(p.lbp[D + c] - p.lbp[c])); }
}

__device__ __forceinline__ void aux_meta_gemm1(const P& p, int gw, int NGW, int lane) {
    const bf16* xb = (const bf16*)(p.ws + WS_XB); const bf16* win = (const bf16*)(p.ws + WS_WIN); const float* lbp = (const float*)(p.ws + WS_LB);
    const int fr = lane & 15, fq = lane >> 4;
    for (int task = gw; task < 384; task += NGW) {
        const int type = task >> 6, cb = (task & 63) * 16;
        int rowA, rowB = 0;
        if (type <= 2) rowA = type * 1024 + cb; else { rowA = 3072 + (type - 3) * 2048 + (cb >> 7) * 256 + (cb & 127); rowB = rowA + 128; }
        const bf16* ap = xb + (size_t)(M + fr) * D + 8 * fq;
        const bf16* b0p = win + (size_t)(rowA + fr) * D + 8 * fq;
        const bf16* b1p = win + (size_t)(rowB + fr) * D + 8 * fq;
        pg8::f32x4 acc0 = {0.f, 0.f, 0.f, 0.f}, acc1 = {0.f, 0.f, 0.f, 0.f};
#pragma unroll 4
        for (int kk = 0; kk < D / 32; ++kk) {
            const bf16x8 a = *(const bf16x8*)(ap + kk * 32), b0 = *(const bf16x8*)(b0p + kk * 32);
            acc0 = __builtin_amdgcn_mfma_f32_16x16x32_bf16(a, b0, acc0, 0, 0, 0);
            if (type >= 3) { const bf16x8 b1 = *(const bf16x8*)(b1p + kk * 32); acc1 = __builtin_amdgcn_mfma_f32_16x16x32_bf16(a, b1, acc1, 0, 0, 0); }
        }
        const int ch = cb + fr; const float lb = lbp[ch];
        bf16* dst = (bf16*)(p.ws + WS_QS + (size_t)(type == 0 ? 0 : type - 1) * (33 * MiB));
#pragma unroll
        for (int e = 0; e < 4; ++e) { const int mrow = 4 * fq + e; const float o = epi1_math(type, acc0[e], acc1[e], lb);
            if (type == 1) ((float*)(p.ws + WS_LOGFM))[(size_t)mrow * D + ch] = o; else dst[(size_t)(M + mrow) * D + ch] = (bf16)f2bf(o); }
    }
}

__device__ __forceinline__ const float* logfrow(const P& p, int r) { return r < M ? p.out + (size_t)r * D : (const float*)(p.ws + WS_LOGFM) + (size_t)(r - M) * D; }
__device__ __forceinline__ int prevrow(int r, int j) {
    if (r < M) { const int t = r % SEQ; return t >= j ? r - j : M + NMETA + (t - j); }
    const int m = r - M; return m >= j ? r - j : -1;
}
__device__ __forceinline__ void naive_hgrn(const P& p, int gw, int lane) {
    if (gw >= BATCH * NH * DH) return;
    const int b = gw / (NH * DH), h = (gw / DH) % NH, vc = gw % DH;
    const bf16* qs = (const bf16*)(p.ws + WS_QS); const bf16* vb = (const bf16*)(p.ws + WS_V); bf16* ob = (bf16*)(p.ws + WS_O);
    float S0 = 0.f, S1 = 0.f;
    for (int t0 = 0; t0 < NMETA + SEQ; t0 += 4) {
        float lf0[4], lf1[4], q0[4], q1[4], vv[4]; int rr[4];
#pragma unroll
        for (int u = 0; u < 4; ++u) {
            const int t = t0 + u; const int r = t < NMETA ? M + t : b * SEQ + (t - NMETA); rr[u] = r;
            const size_t o = (size_t)r * D + h * DH; const float* lf = logfrow(p, r) + h * DH;
            lf0[u] = lf[lane]; lf1[u] = lf[64 + lane]; q0[u] = bf2f(qs[o + lane]); q1[u] = bf2f(qs[o + 64 + lane]); vv[u] = bf2f(vb[o + vc]);
        }
#pragma unroll
        for (int u = 0; u < 4; ++u) {
            const float f0 = __expf(lf0[u]), f1 = __expf(lf1[u]);
            S0 = f0 * S0 + (1.f - f0) * vv[u]; S1 = f1 * S1 + (1.f - f1) * vv[u];
            const float o = wave_sum(q0[u] * S0 + q1[u] * S1);
            if (lane == 0 && (rr[u] < M || b == 0)) ob[(size_t)rr[u] * D + h * DH + vc] = (bf16)f2bf(o);
        }
    }
}
__device__ __forceinline__ void naive_merge(const P& p, int gw, int NGW, int lane) {
    const bf16* ob = (const bf16*)(p.ws + WS_O); const bf16* ga = (const bf16*)(p.ws + WS_GA); const bf16* bg = (const bf16*)(p.ws + WS_BG); const bf16* cx = (const bf16*)(p.ws + WS_CX);
    bf16* merged = (bf16*)(p.ws + WS_MERGED);
    for (int it = gw; it < MR * NH; it += NGW) {
        const int r = it / NH, h = it % NH, c0 = h * DH + lane, c1 = c0 + 64;
        const float o0 = bf2f(ob[(size_t)r * D + c0]), o1 = bf2f(ob[(size_t)r * D + c1]);
        const float rs = 1.f / sqrtf(wave_sum(o0 * o0 + o1 * o1) * (1.f / DH) + EPS);
        const int r1 = prevrow(r, 1), r2 = prevrow(r, 2);
#pragma unroll
        for (int e = 0; e < 2; ++e) {
            const int c = e ? c1 : c0; const float o = e ? o1 : o0;
            const float ya = o * rs * p.hnw[c & (DH - 1)] * bf2f(ga[(size_t)r * D + c]);
            const float x0 = bf2f(cx[(size_t)r * D + c]), x1 = r1 >= 0 ? bf2f(cx[(size_t)r1 * D + c]) : 0.f, x2 = r2 >= 0 ? bf2f(cx[(size_t)r2 * D + c]) : 0.f;
            const float conv = p.cw[c] * x2 + p.cw[D + c] * x1 + p.cw[2 * D + c] * x0;
            merged[(size_t)r * D + c] = (bf16)f2bf(ya + bf2f(bg[(size_t)r * D + c]) * conv);
        }
    }
}
__device__ __forceinline__ const float* h1row(const P& p, int r) { return r < M ? p.out + (size_t)r * D : (const float*)(p.ws + WS_H1M) + (size_t)(r - M) * D; }
__device__ __forceinline__ void naive_gemm2(const P& p, int vbx, int vby, int t256) {
    const int c = vbx * 256 + t256, r0 = vby * 4;
    const bf16* merged = (const bf16*)(p.ws + WS_MERGED);
    float acc[4] = {0.f, 0.f, 0.f, 0.f};
    for (int k = 0; k < D; ++k) { const float w = p.w_out[(size_t)k * D + c];
#pragma unroll
        for (int i = 0; i < 4; ++i) acc[i] += bf2f(merged[(size_t)(r0 + i) * D + k]) * w; }
#pragma unroll
    for (int i = 0; i < 4; ++i) { const int r = r0 + i; const float v = h0row(p, r)[c] + acc[i];
        if (r < M) p.out[(size_t)r * D + c] = v; else ((float*)(p.ws + WS_H1M))[(size_t)(r - M) * D + c] = v; }
}
__device__ __forceinline__ void naive_rstd2(const P& p, int gw, int NGW, int lane) {
    for (int r = gw; r < MR; r += NGW) { const float* xr = h1row(p, r); float s = 0.f;
        for (int k = lane; k < D; k += 64) { const float v = xr[k]; s += v * v; }
        s = wave_sum(s);
        if (lane == 0) ((float*)(p.ws + WS_RSTD2))[r] = 1.f / sqrtf(s * (1.f / D) + EPS); }
}
__device__ __forceinline__ void naive_gemm3(const P& p, int vbx, int vby, int t256) {
    const int c = vbx * 256 + t256, r0 = vby * 4;
    const float* rstd = (const float*)(p.ws + WS_RSTD2);
    int rows[6]; rows[0] = prevrow(r0, 2); rows[1] = prevrow(r0, 1);
#pragma unroll
    for (int i = 0; i < 4; ++i) rows[2 + i] = r0 + i;
    const float* hr[6];
#pragma unroll
    for (int i = 0; i < 6; ++i) hr[i] = h1row(p, rows[i]);
    float aa[6], vv[4];
#pragma unroll
    for (int i = 0; i < 6; ++i) aa[i] = 0.f;
#pragma unroll
    for (int i = 0; i < 4; ++i) vv[i] = 0.f;
    for (int k = 0; k < D; ++k) {
        const float nw = p.fnw[k]; const float wa = p.w_up[(size_t)k * NUP + c] * nw, wv = p.w_up[(size_t)k * NUP + DFF + c] * nw;
#pragma unroll
        for (int i = 0; i < 6; ++i) { const float hv = hr[i][k]; aa[i] += hv * wa; if (i >= 2) vv[i - 2] += hv * wv; }
    }
#pragma unroll
    for (int i = 0; i < 6; ++i) aa[i] *= rstd[rows[i]];
    const float w0 = p.fcw[c], w1 = p.fcw[DFF + c], w2 = p.fcw[2 * DFF + c], bb = p.fcb[c];
    bf16* g = (bf16*)(p.ws + WS_G);
#pragma unroll
    for (int i = 0; i < 4; ++i) { const float a = w0 * aa[i] + w1 * aa[i + 1] + w2 * aa[i + 2] + bb; const float val = vv[i] * rstd[r0 + i];
        g[(size_t)(r0 + i) * DFF + c] = (bf16)f2bf(a * sigm(a) * val); }
}
__device__ __forceinline__ void naive_gemm4(const P& p, int vbx, int vby, int t256) {
    const int c = vbx * 256 + t256, r0 = vby * 4;
    const bf16* g = (const bf16*)(p.ws + WS_G);
    float acc[4] = {0.f, 0.f, 0.f, 0.f};
    for (int k = 0; k < DFF; ++k) { const float w = p.w_down[(size_t)k * D + c];
#pragma unroll
        for (int i = 0; i < 4; ++i) acc[i] += bf2f(g[(size_t)(r0 + i) * DFF + k]) * w; }
#pragma unroll
    for (int i = 0; i < 4; ++i) p.out[(size_t)(r0 + i) * D + c] += acc[i];
}
__device__ __forceinline__ void naive_final(const P& p, int gw, int NGW, int lane) {
    for (int r = gw; r < M; r += NGW) {
        float* xr = p.out + (size_t)r * D; float v[16]; float s = 0.f;
#pragma unroll
        for (int j = 0; j < 16; ++j) { v[j] = xr[lane + 64 * j]; s += v[j] * v[j]; }
        s = wave_sum(s); const float rs = 1.f / sqrtf(s * (1.f / D) + EPS);
#pragma unroll
        for (int j = 0; j < 16; ++j) xr[lane + 64 * j] = v[j] * rs * p.finw[lane + 64 * j];
    }
}
#define XB_TMO      128
#define XB_XCNT(j)  (256  + 64 * (j))
#define XB_XSUB(j)  (1280 + 64 * (j))
#define XB_XGEN(j)  (2304 + 64 * (j))
#define XB_TOP      3328
#define XB_TOPGEN   3392
#define XCD_BAR_WORDS 3456
#define XB_SPIN_CAP (1u << 18)

__device__ __forceinline__ unsigned xb_ld(unsigned* p)              { return __hip_atomic_load(p, __ATOMIC_RELAXED, __HIP_MEMORY_SCOPE_AGENT); }
__device__ __forceinline__ unsigned xb_add(unsigned* p, unsigned v) { return __hip_atomic_fetch_add(p, v, __ATOMIC_RELAXED, __HIP_MEMORY_SCOPE_AGENT); }
__device__ __forceinline__ unsigned xb_xcc_id() { return (unsigned)__builtin_amdgcn_s_getreg((3 << 11) | 20) & 0xFu; }
#define XB_SPIN(cond, bar) do { unsigned _sp = 0; while (cond) { __builtin_amdgcn_s_sleep(1); \
    if ((++_sp & 255u) == 0u) { if (xb_ld(&(bar)[XB_TMO])) break; if (_sp > XB_SPIN_CAP) { atomicAdd(&(bar)[XB_TMO], 1u); break; } } } } while (0)

struct XcdBarrier {
    unsigned* bar; unsigned x;
    volatile LAS unsigned* st;
};

__device__ __forceinline__ XcdBarrier xcd_barrier_post(unsigned* bar, volatile LAS unsigned* st) {
    XcdBarrier b; b.bar = bar; b.x = xb_xcc_id(); b.st = st;
    if (threadIdx.x == 0) (void)xb_add(&bar[XB_XCNT(b.x)], 1u);
    return b;
}
__device__ __forceinline__ void xcd_barrier_complete(unsigned* bar, unsigned x, unsigned& nloc, unsigned& nx) {
    const unsigned G = gridDim.x * gridDim.y * gridDim.z;
    unsigned sum, cnt, mine, sp = 0u;
    for (;;) {
        sum = 0u; cnt = 0u; mine = 0u;
#pragma unroll
        for (unsigned j = 0; j < 16; ++j) { const unsigned c = xb_ld(&bar[XB_XCNT(j)]); sum += c; cnt += (c > 0u) ? 1u : 0u; mine = (j == x) ? c : mine; }
        if (sum == G) break;
        __builtin_amdgcn_s_sleep(1);
        if ((++sp & 255u) == 0u) { if (xb_ld(&bar[XB_TMO])) break; if (sp > XB_SPIN_CAP) { atomicAdd(&bar[XB_TMO], 1u); break; } }
    }
    nloc = mine > 0u ? mine : 1u; nx = cnt > 0u ? cnt : 1u;
}

__device__ __forceinline__ void xcd_barrier(const XcdBarrier& b) {
    asm volatile("s_waitcnt vmcnt(0)" ::: "memory");
    __syncthreads();
    if (threadIdx.x == 0) {
        unsigned* bar = b.bar;
        __builtin_amdgcn_s_waitcnt(0);
        unsigned nloc = b.st[0], nx = b.st[1];
        if (nloc == 0u) { xcd_barrier_complete(bar, b.x, nloc, nx); b.st[0] = nloc; b.st[1] = nx; }
        const unsigned old = xb_add(&bar[XB_XSUB(b.x)], 1u);
        const unsigned gen = old / nloc;
        if (old + 1u == (gen + 1u) * nloc) {
            __builtin_amdgcn_fence(__ATOMIC_RELEASE, "agent");
            asm volatile("s_waitcnt vmcnt(0)" ::: "memory");
            const unsigned og = xb_add(&bar[XB_TOP], 1u);
            const unsigned tg = og / nx;
            if (og + 1u == (tg + 1u) * nx) xb_add(&bar[XB_TOPGEN], 1u);
            else XB_SPIN(xb_ld(&bar[XB_TOPGEN]) == tg, bar);
            __builtin_amdgcn_fence(__ATOMIC_ACQUIRE, "agent");
            xb_add(&bar[XB_XGEN(b.x)], 1u);
            asm volatile("s_waitcnt vmcnt(0)" ::: "memory");
        } else {
            XB_SPIN(xb_ld(&bar[XB_XGEN(b.x)]) == gen, bar);
            __builtin_amdgcn_fence(__ATOMIC_ACQUIRE, "agent");
            asm volatile("s_waitcnt vmcnt(0)" ::: "memory");
        }
    }
    __syncthreads();
}

struct Args { P p; int ph_lo, ph_hi; };
__global__ void __launch_bounds__(NWAVES * 64, 2) fwd_mega(Args args) {
    extern __shared__ __attribute__((aligned(16))) unsigned char lds_raw[];
    LAS unsigned char* lds = (LAS unsigned char*)lds_raw;
    volatile LAS unsigned* MISC = (volatile LAS unsigned*)(lds + MISC_OFF);
    const P& p = args.p;
    const int tid = threadIdx.x, lane = tid & 63, wave = __builtin_amdgcn_readfirstlane(tid >> 6);
    const int G = gridDim.x, bx = blockIdx.x, vcu = (G % 8 == 0) ? (bx % 8) * (G / 8) + bx / 8 : bx;
    const int gw = vcu * NWAVES + wave, NGW = G * NWAVES;
    gu32* ctl = (gu32*)(p.ws + WS_CTL);
    for (int u = tid; u < (LDS_BYTES - LDSCTL_OFF) / 4; u += NWAVES * 64) ((LAS unsigned*)(lds + LDSCTL_OFF))[u] = 0u;
    __syncthreads();
    XcdBarrier bar = xcd_barrier_post((unsigned*)(ctl + CW_BAR), MISC + 8);
    const int lo = args.ph_lo, hi = args.ph_hi;
#define IN(k) (lo <= (k) && (k) < hi)
#define SEAM(k) do { if (IN(k) && IN((k) + 1)) xcd_barrier(bar); } while (0)

    if (IN(0)) { p0_prologue(p, lds, vcu, G, wave, lane); }
    SEAM(0);
    if (IN(1)) {
        pg8::Gemm g{(const bf16*)(p.ws + WS_XB), (const bf16*)(p.ws + WS_WIN), M, NIN, D}; pg8::StaticOrder S; S.init(M, NIN, G, bx);
        Epi1 E{p.ws, p.out, (const float*)(p.ws + WS_LB)};
        pg8::gemm_phase<Epi1, pg8::StaticOrder, true, true>(lds, g, S, E);
        aux_meta_gemm1(p, gw, NGW, lane);
    }
    SEAM(1);
    if (IN(2)) { naive_hgrn(p, gw, lane); }
    SEAM(2);
    if (IN(3)) { naive_merge(p, gw, NGW, lane); }
    SEAM(3);
    if (IN(4)) { for (int vb = bx * 2 + (tid >> 8); vb < (D / 256) * (MR / 4); vb += 2 * G) naive_gemm2(p, vb % (D / 256), vb / (D / 256), tid & 255); }
    SEAM(4);
    if (IN(5)) { naive_rstd2(p, gw, NGW, lane); }
    SEAM(5);
    if (IN(6)) { for (int vb = bx * 2 + (tid >> 8); vb < (DFF / 256) * (M / 4); vb += 2 * G) naive_gemm3(p, vb % (DFF / 256), vb / (DFF / 256), tid & 255); }
    SEAM(6);
    if (IN(7)) { for (int vb = bx * 2 + (tid >> 8); vb < (D / 256) * (M / 4); vb += 2 * G) naive_gemm4(p, vb % (D / 256), vb / (D / 256), tid & 255); }
    SEAM(7);
    if (IN(8)) { naive_final(p, gw, NGW, lane); }
#undef IN
#undef SEAM
}

constexpr int N_PHASES = 9;
#ifndef MK_N_LAUNCHES
#define MK_N_LAUNCHES 1
#endif
extern "C" void kernel_launch(void* const* d_in, const int* in_sizes, int n_in, void* d_out, int out_size, void* d_ws, size_t ws_size, hipStream_t stream) {
    static int grid = 0;
    if (grid == 0) {
        if (n_in != 14 || in_sizes[0] != M * D || out_size != M * D || ws_size < WS_END) { fprintf(stderr, "kernel_launch: unexpected shapes (n_in %d, in0 %d, out %d, ws %zu)\n", n_in, n_in > 0 ? in_sizes[0] : -1, out_size, ws_size); grid = -1; return; }
        int dev = 0, cus = 0, per_cu = 0;
        if (hipGetDevice(&dev) != hipSuccess || hipDeviceGetAttribute(&cus, hipDeviceAttributeMultiprocessorCount, dev) != hipSuccess) { grid = -1; return; }
        if (hipFuncSetAttribute((const void*)fwd_mega, hipFuncAttributeMaxDynamicSharedMemorySize, LDS_BYTES) != hipSuccess) { fprintf(stderr, "kernel_launch: hipFuncSetAttribute failed\n"); grid = -1; return; }
        if (hipOccupancyMaxActiveBlocksPerMultiprocessor(&per_cu, (const void*)fwd_mega, NWAVES * 64, LDS_BYTES) != hipSuccess || per_cu < 1) { fprintf(stderr, "kernel_launch: occupancy query says %d blocks per CU\n", per_cu); per_cu = 1; }
        (void)hipGetLastError();
        grid = cus;
    }
    if (grid < 0) return;
    if (hipMemsetAsync((char*)d_ws + WS_CTL, 0, CTL_ZERO_BYTES, stream) != hipSuccess) { fprintf(stderr, "kernel_launch: memset failed\n"); return; }
    Args a{};
    const float** f = (const float**)&a.p;
    for (int i = 0; i < 14; ++i) f[i] = (const float*)d_in[i];
    a.p.out = (float*)d_out; a.p.ws = (unsigned char*)d_ws;
    if (MK_N_LAUNCHES == 1) { a.ph_lo = 0; a.ph_hi = N_PHASES; hipLaunchKernelGGL(fwd_mega, dim3(grid), dim3(NWAVES * 64), LDS_BYTES, stream, a); }
    else for (int li = 0; li < N_PHASES; ++li) { a.ph_lo = li; a.ph_hi = li + 1; hipLaunchKernelGGL(fwd_mega, dim3(grid), dim3(NWAVES * 64), LDS_BYTES, stream, a); }
}
```

```cpp
#include <hip/hip_runtime.h>
#include <cstdint>
#include <cstdio>
namespace pg8 {
#define PG8_LAS __attribute__((address_space(3)))
typedef unsigned short bf16_t;
typedef short bf16x8 __attribute__((ext_vector_type(8)));
typedef float f32x4 __attribute__((ext_vector_type(4)));
typedef unsigned u32x4 __attribute__((ext_vector_type(4)));
constexpr int BM = 256, BK = 64, HALF = 128, HTB = HALF * BK * 2  , STAGE_BYTES = 8 * HTB, NXCD = 8, WGM = 8;

__host__ __device__ __forceinline__ int lds_byte(int r, int c) { const int st = (r >> 4) * 2 + (c >> 5), rr = r & 15, cc = c & 31, ob = rr * 64 + cc * 2; return st * 1024 + (ob ^ (((ob >> 9) & 1) << 5)); }
__host__ __device__ __forceinline__ void stage_rc(int b, int& R, int& C) { const int st = b / 1024, sb = b % 1024, swz = sb ^ (((sb >> 9) & 1) << 5); R = (st >> 1) * 16 + swz / 64; C = (st & 1) * 32 + (swz % 64) / 2; }
__host__ __device__ __forceinline__ int perm32(int rho) { const int n = rho >> 4, i = rho & 15; return 8 * (i >> 2) + 4 * n + (i & 3); }

struct Unit { int pm, pn; };
struct Gemm { const bf16_t* A; const bf16_t* Bt; int M, N, K; };

struct StaticOrder {
    int nM, nN, nwg, G, c;
    __host__ __device__ void init(int M, int N, int G_, int c_) { nM = M / BM; nN = N / BM; nwg = nM * nN; G = G_; c = c_; }
    __host__ __device__ bool next(int i, Unit& u) const {
        const long L = (long)i * G + c; if (L >= nwg) return false;
        int wgid = (int)L; { const int q = nwg / NXCD, r = nwg % NXCD, xcd = wgid % NXCD, off = wgid / NXCD; wgid = (xcd < r ? xcd * (q + 1) : r * (q + 1) + (xcd - r) * q) + off; }
        const int nig = WGM * nN, gid = wgid / nig, fm = gid * WGM, gsz = (nM - fm) < WGM ? (nM - fm) : WGM;
        u.pm = fm + ((wgid % nig) % gsz); u.pn = (wgid % nig) / gsz; return true;
    }
    __device__ __forceinline__ size_t a_off(const Unit& u, size_t tstep) const { return (size_t)u.pm * tstep; }
    __device__ __forceinline__ void a_ready(const Unit&) const {}
    __device__ __forceinline__ void done(const Unit&) const {}
};

__device__ __forceinline__ unsigned cvt_pk_bf16(float lo, float hi) { unsigned r; asm volatile("v_cvt_pk_bf16_f32 %0, %1, %2" : "=v"(r) : "v"(lo), "v"(hi)); return r; }
template <class Epi, class Sched, bool ALIGN_EPI = false, bool SP2 = false>
__device__ __forceinline__ void gemm_phase(PG8_LAS unsigned char* lds, const Gemm g, const Sched& S, const Epi& E) {
    const int tid = threadIdx.x, wid = __builtin_amdgcn_readfirstlane(tid >> 6), lane = tid & 63, wr = wid >> 2, wc = wid & 3, fr = lane & 15, fq = lane >> 4;
    const int K = g.K, nt = K / BK;
    unsigned voffA[2], voffB[2];
#pragma unroll
    for (int i = 0; i < 2; ++i) { int R, C; stage_rc(tid * 16 + i * 8192, R, C); const int Rb = Epi::PERM ? ((R & ~31) + perm32(R & 31)) : R;
        voffA[i] = (unsigned)(R * K + C) * 2u; voffB[i] = (unsigned)(Rb * K + C) * 2u; }
    const size_t kstep = (size_t)(BK * 2);
    const size_t hstep = (size_t)HALF * K * 2;
    const size_t tstep = 2 * hstep;
    const unsigned ldsw = (unsigned)wid * 1024u;
    const int aoff = lds_byte(wr * 64 + fr, fq * 8), boff = lds_byte(wc * 32 + fr, fq * 8);
#define PG8_SA(b, h) (((b) * 2 + (h)) * HTB)
#define PG8_SB(b, h) ((4 + (b) * 2 + (h)) * HTB)
#define PG8_STAGE(bufoff, gbase, voff) do { _Pragma("unroll") for (int _i = 0; _i < 2; ++_i) \
        __builtin_amdgcn_global_load_lds((const unsigned*)((const char*)(gbase) + (voff)[_i]), (PG8_LAS unsigned*)(lds + (bufoff) + ldsw + _i * 8192), 16, 0, 0); } while (0)
#define PG8_LDA(dst, b, h) do { _Pragma("unroll") for (int m = 0; m < 4; ++m) _Pragma("unroll") for (int k = 0; k < 2; ++k) dst[m][k] = *(const PG8_LAS bf16x8*)(lds + PG8_SA(b, h) + aoff + m * 2048 + k * 1024); } while (0)
#define PG8_LDB(dst, b, h) do { _Pragma("unroll") for (int n = 0; n < 2; ++n) _Pragma("unroll") for (int k = 0; k < 2; ++k) dst[n][k] = *(const PG8_LAS bf16x8*)(lds + PG8_SB(b, h) + boff + n * 2048 + k * 1024); } while (0)
#define PG8_MMA(ai, bj, At, Bt) do { __builtin_amdgcn_s_setprio(1); _Pragma("unroll") for (int m = 0; m < 4; ++m) _Pragma("unroll") for (int n = 0; n < 2; ++n) _Pragma("unroll") for (int k = 0; k < 2; ++k) \
        acc[ai][bj][m][n] = __builtin_amdgcn_mfma_f32_16x16x32_bf16(Bt[n][k], At[m][k], acc[ai][bj][m][n], 0, 0, 0); __builtin_amdgcn_s_setprio(0); } while (0)
#define PG8_WAIT_V(n) asm volatile("s_waitcnt vmcnt(" #n ")" ::: "memory")
#define PG8_WAIT_L(n) asm volatile("s_waitcnt lgkmcnt(" #n ")" ::: "memory")
#define PG8_BAR __builtin_amdgcn_s_barrier()
#define PG8_SCHED __builtin_amdgcn_sched_barrier(0)
    Unit cur, nxt; int ui = 0;
    if (!S.next(0, cur)) return;
    f32x4 acc[2][2][4][2];
#pragma unroll
    for (int a = 0; a < 2; ++a)
#pragma unroll
        for (int b = 0; b < 2; ++b)
#pragma unroll
            for (int m = 0; m < 4; ++m)
#pragma unroll
                for (int n = 0; n < 2; ++n) acc[a][b][m][n] = (f32x4){0.f, 0.f, 0.f, 0.f};
    bf16x8 At[4][2], B0[2][2], B1[2][2];
    const char* cA = (const char*)g.A + S.a_off(cur, tstep); const char* cB = (const char*)g.Bt + (size_t)cur.pn * tstep;
    S.a_ready(cur);
    if constexpr (SP2) {
        PG8_STAGE(PG8_SB(0, 0), cB, voffB); PG8_STAGE(PG8_SB(0, 1), cB + hstep, voffB); PG8_STAGE(PG8_SA(0, 0), cA, voffA); PG8_STAGE(PG8_SA(0, 1), cA + hstep, voffA);
        if (wr == 1) PG8_BAR;
        PG8_WAIT_V(2); PG8_BAR;
        PG8_STAGE(PG8_SB(1, 0), cB + kstep, voffB); PG8_STAGE(PG8_SA(1, 0), cA + kstep, voffA); PG8_STAGE(PG8_SB(1, 1), cB + hstep + kstep, voffB);
        PG8_WAIT_V(6); PG8_BAR;
    } else {
        PG8_STAGE(PG8_SB(0, 0), cB, voffB); PG8_STAGE(PG8_SA(0, 0), cA, voffA); PG8_STAGE(PG8_SB(0, 1), cB + hstep, voffB); PG8_STAGE(PG8_SA(0, 1), cA + hstep, voffA);
        if (wr == 1) PG8_BAR;
        PG8_WAIT_V(4); PG8_BAR;
        PG8_STAGE(PG8_SB(1, 0), cB + kstep, voffB); PG8_STAGE(PG8_SA(1, 0), cA + kstep, voffA); PG8_STAGE(PG8_SB(1, 1), cB + hstep + kstep, voffB);
        PG8_WAIT_V(6); PG8_BAR;
    }
    for (;;) {
        const bool has_next = S.next(ui + 1, nxt);
        const char* nA = has_next ? (const char*)g.A + S.a_off(nxt, tstep) : cA; const char* nB = has_next ? (const char*)g.Bt + (size_t)nxt.pn * tstep : cB;
        for (int t = 0; t < nt; t += 2) {
            const bool last = (t == nt - 2);
            const char* a1 = cA + (size_t)(t + 1) * kstep;
            const char* a2 = last ? nA : cA + (size_t)(t + 2) * kstep; const char* b2 = last ? nB : cB + (size_t)(t + 2) * kstep;
            const char* a3 = a2 + kstep; const char* b3 = b2 + kstep;
            if (last && has_next) S.a_ready(nxt);
            if constexpr (SP2) {
            PG8_LDB(B0, 0, 0); PG8_LDB(B1, 0, 1); PG8_SCHED; PG8_LDA(At, 0, 0); PG8_STAGE(PG8_SA(1, 1), a1 + hstep, voffA);
            PG8_WAIT_V(8); PG8_WAIT_L(0); PG8_BAR; PG8_MMA(0, 0, At, B0); PG8_MMA(0, 1, At, B1); PG8_BAR; PG8_SCHED;
            PG8_LDA(At, 0, 1); PG8_STAGE(PG8_SB(0, 0), b2, voffB); PG8_STAGE(PG8_SB(0, 1), b2 + hstep, voffB); PG8_STAGE(PG8_SA(0, 0), a2, voffA);
            PG8_WAIT_V(8); PG8_WAIT_L(0); PG8_BAR; PG8_MMA(1, 0, At, B0); PG8_MMA(1, 1, At, B1); PG8_BAR; PG8_SCHED;
            PG8_LDB(B0, 1, 0); PG8_LDB(B1, 1, 1); PG8_SCHED; PG8_LDA(At, 1, 0); PG8_STAGE(PG8_SA(0, 1), a2 + hstep, voffA);
            PG8_WAIT_V(8); PG8_WAIT_L(0); PG8_BAR; PG8_MMA(0, 0, At, B0); PG8_MMA(0, 1, At, B1); PG8_BAR; PG8_SCHED;
            PG8_LDA(At, 1, 1); PG8_STAGE(PG8_SB(1, 0), b3, voffB); PG8_STAGE(PG8_SB(1, 1), b3 + hstep, voffB); PG8_STAGE(PG8_SA(1, 0), a3, voffA);
            PG8_WAIT_V(8); PG8_WAIT_L(0); PG8_BAR; PG8_MMA(1, 0, At, B0); PG8_MMA(1, 1, At, B1); PG8_BAR; PG8_SCHED;
            } else {
            PG8_LDB(B0, 0, 0); PG8_SCHED; PG8_LDA(At, 0, 0); PG8_STAGE(PG8_SA(1, 1), a1 + hstep, voffA);
            PG8_WAIT_L(8); PG8_BAR; PG8_WAIT_L(0); PG8_MMA(0, 0, At, B0); PG8_BAR; PG8_SCHED;
            PG8_LDB(B1, 0, 1); PG8_STAGE(PG8_SB(0, 0), b2, voffB);
            PG8_BAR; PG8_WAIT_L(0); PG8_MMA(0, 1, At, B1); PG8_BAR;
            PG8_LDA(At, 0, 1); PG8_STAGE(PG8_SA(0, 0), a2, voffA);
            PG8_BAR; PG8_WAIT_L(0); PG8_MMA(1, 0, At, B0); PG8_BAR; PG8_SCHED;
            PG8_STAGE(PG8_SB(0, 1), b2 + hstep, voffB);
            PG8_WAIT_V(6); PG8_BAR; PG8_MMA(1, 1, At, B1); PG8_BAR;
            PG8_LDB(B0, 1, 0); PG8_SCHED; PG8_LDA(At, 1, 0); PG8_STAGE(PG8_SA(0, 1), a2 + hstep, voffA);
            PG8_WAIT_L(8); PG8_BAR; PG8_WAIT_L(0); PG8_MMA(0, 0, At, B0); PG8_BAR; PG8_SCHED;
            PG8_LDB(B1, 1, 1); PG8_STAGE(PG8_SB(1, 0), b3, voffB);
            PG8_BAR; PG8_WAIT_L(0); PG8_MMA(0, 1, At, B1); PG8_BAR;
            PG8_LDA(At, 1, 1); PG8_STAGE(PG8_SA(1, 0), a3, voffA);
            PG8_BAR; PG8_WAIT_L(0); PG8_MMA(1, 0, At, B0); PG8_BAR; PG8_SCHED;
            PG8_STAGE(PG8_SB(1, 1), b3 + hstep, voffB);
            PG8_WAIT_V(6); PG8_BAR; PG8_MMA(1, 1, At, B1); PG8_BAR;
            }
        }
        if constexpr (ALIGN_EPI) { if (wr == 0) PG8_BAR; }
        if constexpr (!Epi::AFTER_DRAIN) { E(acc, cur, wr, wc, fr, fq); S.done(cur); }
        if (!has_next) break;
#pragma unroll
        for (int a = 0; a < 2; ++a)
#pragma unroll
            for (int b = 0; b < 2; ++b)
#pragma unroll
                for (int m = 0; m < 4; ++m)
#pragma unroll
                    for (int n = 0; n < 2; ++n) acc[a][b][m][n] = (f32x4){0.f, 0.f, 0.f, 0.f};
        cur = nxt; cA = nA; cB = nB; ++ui;
        if constexpr (ALIGN_EPI) { if (wr == 1) PG8_BAR; }
    }
    PG8_WAIT_V(0);
    if constexpr (!ALIGN_EPI) { if (wr == 0) PG8_BAR; }
    PG8_BAR;
    if constexpr (Epi::AFTER_DRAIN) { E.fused(acc, cur, wr, wc, fr, fq, lds, wid, lane); S.done(cur); }
#undef PG8_SA
#undef PG8_SB
#undef PG8_STAGE
#undef PG8_LDA
#undef PG8_LDB
#undef PG8_MMA
#undef PG8_WAIT_V
#undef PG8_WAIT_L
#undef PG8_BAR
#undef PG8_SCHED
}
}

constexpr int NWAVES = 8;
constexpr int D = 1024, BATCH = 2, SEQ = 8192, NMETA = 16, M = BATCH * SEQ, MR = M + NMETA;
constexpr int NH = 8, DH = 128, DFF = 2816, NIN = 9 * D, NUP = 2 * DFF;
constexpr float EPS = 1e-6f;
typedef unsigned short bf16;
typedef float f32x4 __attribute__((ext_vector_type(4)));
typedef unsigned u32x4 __attribute__((ext_vector_type(4)));
typedef short bf16x8 __attribute__((ext_vector_type(8)));
#define GAS __attribute__((address_space(1)))
#define LAS __attribute__((address_space(3)))
typedef GAS unsigned gu32;
#define RLX_AGENT __ATOMIC_RELAXED, __HIP_MEMORY_SCOPE_AGENT
#define LDS_WAIT() asm volatile("s_waitcnt lgkmcnt(0)" ::: "memory")
#define VM_WAIT() asm volatile("s_waitcnt vmcnt(0)" ::: "memory")

constexpr size_t MiB = 1u << 20;
constexpr size_t WS_CTL = 0, CTL_ZERO_BYTES = 1 * MiB;
constexpr int CW_BAR = 4096;
constexpr size_t WS_RSS2 = 128 * 1024;
constexpr size_t WS_RSS3 = 256 * 1024;
constexpr size_t WS_LB = 1 * MiB;
constexpr size_t WS_LOGFM = WS_LB + 64 * 1024;
constexpr size_t WS_H1M = WS_LB + 128 * 1024;
constexpr size_t WS_RSTD2 = WS_LB + 192 * 1024;
constexpr size_t WS_WIN = 2 * MiB, WS_WOUT = 20 * MiB, WS_WUP = 22 * MiB, WS_WDN = 33 * MiB;
constexpr size_t WS_XB = 40 * MiB;
constexpr size_t WS_QS = 73 * MiB, WS_V = 106 * MiB, WS_GA = 139 * MiB, WS_BG = 172 * MiB, WS_CX = 205 * MiB;
constexpr size_t WS_O = WS_XB;
constexpr size_t WS_MERGED = WS_QS;
constexpr size_t WS_G = WS_V;
constexpr size_t WS_END = 256 * MiB;
static_assert(WS_V == WS_QS + 33 * MiB && WS_GA == WS_QS + 66 * MiB && WS_BG == WS_QS + 99 * MiB && WS_CX == WS_QS + 132 * MiB, "gate buffers are 33 MiB apart");

constexpr int RING_BYTES = 131072, LDSCTL_OFF = RING_BYTES, MISC_OFF = LDSCTL_OFF + 320, LDS_BYTES = 147456;

__device__ __forceinline__ unsigned f2bf(float f) { unsigned u = __builtin_bit_cast(unsigned, f); return (u + 0x7fffu + ((u >> 16) & 1u)) >> 16; }
__device__ __forceinline__ unsigned pk2(float lo, float hi) { return f2bf(lo) | (f2bf(hi) << 16); }
__device__ __forceinline__ float bf2f(bf16 h) { return __builtin_bit_cast(float, (unsigned)h << 16); }
__device__ __forceinline__ float sigm(float x) { return __builtin_amdgcn_rcpf(1.f + __expf(-x)); }
__device__ __forceinline__ float wave_sum(float v) {
#pragma unroll
    for (int o = 1; o < 64; o <<= 1) v += __shfl_xor(v, o);
    return v;
}

struct P {
    const float *x, *meta, *lbp, *anw, *w_in, *hnw, *cw, *w_out, *fnw, *w_up, *fcw, *fcb, *w_down, *finw;
    float* out; unsigned char* ws;
};

__device__ __forceinline__ float epi1_math(int type, float a, float b, float lb) {
    switch (type) {
        case 0: return a * sigm(a);
        case 1: return __logf(lb + (1.f - lb) * sigm(a));
        case 2: return a;
        case 3: return sigm(b) * a * sigm(a);
        case 4: return sigm(b) * a;
        default: return a * b;
    }
}
struct Epi1 {
    static constexpr bool PERM = true, AFTER_DRAIN = false;
    unsigned char* ws; float* logf; const float* lb;
    __device__ __forceinline__ void operator()(const pg8::f32x4 (&acc)[2][2][4][2], const pg8::Unit& u, int wr, int wc, int fr, int fq) const {
        const int pn = u.pn, type = pn < 12 ? (pn >> 2) : 3 + ((pn - 12) >> 3);
        const int row0 = u.pm * 256 + wr * 64 + fr;
        if (type <= 2) {
            const int cb = (pn & 3) * 256 + wc * 32 + 8 * fq;
            if (type == 1) {
                float lbv[2][8];
#pragma unroll
                for (int bj = 0; bj < 2; ++bj)
#pragma unroll
                    for (int e = 0; e < 8; ++e) lbv[bj][e] = lb[cb + bj * 128 + e];
#pragma unroll
                for (int ai = 0; ai < 2; ++ai)
#pragma unroll
                    for (int m = 0; m < 4; ++m) { float* rowp = logf + (size_t)(row0 + ai * 128 + m * 16) * D + cb;
#pragma unroll
                        for (int bj = 0; bj < 2; ++bj) { pg8::f32x4 o0, o1;
#pragma unroll
                            for (int e = 0; e < 4; ++e) { o0[e] = epi1_math(1, acc[ai][bj][m][0][e], 0.f, lbv[bj][e]); o1[e] = epi1_math(1, acc[ai][bj][m][1][e], 0.f, lbv[bj][4 + e]); }
                            *(pg8::f32x4*)(rowp + bj * 128) = o0; *(pg8::f32x4*)(rowp + bj * 128 + 4) = o1; } }
            } else {
                bf16* base = (bf16*)(ws + WS_QS + (size_t)(type == 0 ? 0 : 1) * (33 * MiB));
#pragma unroll
                for (int ai = 0; ai < 2; ++ai)
#pragma unroll
                    for (int m = 0; m < 4; ++m) { bf16* rowp = base + (size_t)(row0 + ai * 128 + m * 16) * D + cb;
#pragma unroll
                        for (int bj = 0; bj < 2; ++bj) { pg8::f32x4 v0 = acc[ai][bj][m][0], v1 = acc[ai][bj][m][1];
                            if (type == 0) {
#pragma unroll
                                for (int e = 0; e < 4; ++e) { v0[e] = epi1_math(0, v0[e], 0.f, 0.f); v1[e] = epi1_math(0, v1[e], 0.f, 0.f); } }
                            pg8::u32x4 w; w.x = pg8::cvt_pk_bf16(v0[0], v0[1]); w.y = pg8::cvt_pk_bf16(v0[2], v0[3]); w.z = pg8::cvt_pk_bf16(v1[0], v1[1]); w.w = pg8::cvt_pk_bf16(v1[2], v1[3]);
                            *(pg8::u32x4*)(rowp + bj * 128) = w; } }
            }
        } else {
            const int cb = ((pn - 12) & 7) * 128 + wc * 32 + 8 * fq;
            bf16* base = (bf16*)(ws + WS_QS + (size_t)(type - 1) * (33 * MiB));
#pragma unroll
            for (int ai = 0; ai < 2; ++ai)
#pragma unroll
                for (int m = 0; m < 4; ++m) { bf16* rowp = base + (size_t)(row0 + ai * 128 + m * 16) * D + cb;
                    const pg8::f32x4 a0 = acc[ai][0][m][0], a1 = acc[ai][0][m][1], b0 = acc[ai][1][m][0], b1 = acc[ai][1][m][1]; pg8::f32x4 v0, v1;
                    if (type == 3) {
#pragma unroll
                        for (int e = 0; e < 4; ++e) { v0[e] = epi1_math(3, a0[e], b0[e], 0.f); v1[e] = epi1_math(3, a1[e], b1[e], 0.f); }
                    } else if (type == 4) {
#pragma unroll
                        for (int e = 0; e < 4; ++e) { v0[e] = epi1_math(4, a0[e], b0[e], 0.f); v1[e] = epi1_math(4, a1[e], b1[e], 0.f); }
                    } else { v0 = a0 * b0; v1 = a1 * b1; }
                    pg8::u32x4 w; w.x = pg8::cvt_pk_bf16(v0[0], v0[1]); w.y = pg8::cvt_pk_bf16(v0[2], v0[3]); w.z = pg8::cvt_pk_bf16(v1[0], v1[1]); w.w = pg8::cvt_pk_bf16(v1[2], v1[3]);
                    *(pg8::u32x4*)rowp = w; }
        }
    }
};

__host__ __device__ __forceinline__ int win_dst_row(int n) {
    const int g = n >> 10, c = n & 1023, pr = (c >> 7) * 256 + (c & 127);
    switch (g) { case 0: case 1: case 2: return n; case 3: return 3072 + pr; case 7: return 3072 + 128 + pr; case 4: return 5120 + pr; case 8: return 5120 + 128 + pr; case 5: return 7168 + pr; default: return 7168 + 128 + pr; }
}
__host__ __device__ __forceinline__ int wup_dst_row(int n) { const int c = n < DFF ? n : n - DFF; return (c >> 7) * 256 + (c & 127) + (n < DFF ? 0 : 128); }

__device__ __forceinline__ void p0_transpose_item(const float* W, int K, int N, bf16* WT, int dst_row0, const float* kscale, LAS float* scr, int k0, int n0, int lane) {
#pragma unroll 8
    for (int i = 0; i < 32; ++i) { const int kk = 2 * i + (lane >> 5); float w = W[(size_t)(k0 + kk) * N + n0 + (lane & 31)]; if (kscale) w *= kscale[k0 + kk]; scr[kk * 33 + (lane & 31)] = w; }
    LDS_WAIT(); asm volatile("" ::: "memory");
    const int c = lane & 7;
#pragma unroll
    for (int j = 0; j < 4; ++j) { const int n = (lane >> 3) + 8 * j; const LAS float* s = scr + (8 * c) * 33 + n;
        u32x4 o; o.x = pk2(s[0 * 33], s[1 * 33]); o.y = pk2(s[2 * 33], s[3 * 33]); o.z = pk2(s[4 * 33], s[5 * 33]); o.w = pk2(s[6 * 33], s[7 * 33]);
        *(GAS u32x4*)(WT + (size_t)(dst_row0 + n) * K + k0 + 8 * c) = o; }
    LDS_WAIT(); asm volatile("" ::: "memory");
}
__device__ __forceinline__ const float* h0row(const P& p, int r) { return r < M ? p.x + (size_t)r * D : p.meta + (size_t)(r - M) * D; }
__device__ __forceinline__ void p0_prologue(const P& p, LAS unsigned char* lds, int vcu, int G, int wave, int lane) {
    LAS float* scr = (LAS float*)(lds + wave * 16384);
    const int gw = vcu * NWAVES + wave, NGW = G * NWAVES;
    constexpr int I_IN = (D / 64) * (NIN / 32), I_OUT = (D / 64) * (D / 32), I_UP = (D / 64) * (NUP / 32), I_DN = (DFF / 64) * (D / 32);
    constexpr int NITEMS = I_IN + I_OUT + I_UP + I_DN;
    bf16* win = (bf16*)(p.ws + WS_WIN); bf16* wout = (bf16*)(p.ws + WS_WOUT); bf16* wup = (bf16*)(p.ws + WS_WUP); bf16* wdn = (bf16*)(p.ws + WS_WDN);
    for (int it = gw; it < NITEMS; it += NGW) {
        int r = it;
        if (r < I_IN) { const int nblk = NIN / 32, kb = r / nblk, nb = r % nblk; p0_transpose_item(p.w_in, D, NIN, win, win_dst_row(32 * nb), p.anw, scr, 64 * kb, 32 * nb, lane); continue; } r -= I_IN;
        if (r < I_OUT) { const int nblk = D / 32, kb = r / nblk, nb = r % nblk; p0_transpose_item(p.w_out, D, D, wout, 32 * nb, nullptr, scr, 64 * kb, 32 * nb, lane); continue; } r -= I_OUT;
        if (r < I_UP) { const int nblk = NUP / 32, kb = r / nblk, nb = r % nblk; p0_transpose_item(p.w_up, D, NUP, wup, wup_dst_row(32 * nb), p.fnw, scr, 64 * kb, 32 * nb, lane); continue; } r -= I_UP;
        { const int nblk = D / 32, kb = r / nblk, nb = r % nblk; p0_transpose_item(p.w_down, DFF, D, wdn, 32 * nb, nullptr, scr, 64 * kb, 32 * nb, lane); }
    }
    bf16* xb = (bf16*)(p.ws + WS_XB);
    for (int m = gw; m < MR; m += NGW) {
        const GAS f32x4* xr = (const GAS f32x4*)h0row(p, m) + lane;
        f32x4 v[4]; float s = 0.f;
#pragma unroll
        for (int j = 0; j < 4; ++j) { v[j] = xr[64 * j]; s += (v[j].x * v[j].x + v[j].y * v[j].y) + (v[j].z * v[j].z + v[j].w * v[j].w); }
        const float rstd = 1.f / sqrtf(wave_sum(s) * (1.f / D) + EPS);
        GAS unsigned long long* o8 = (GAS unsigned long long*)(xb + (size_t)m * D) + lane;
#pragma unroll
        for (int j = 0; j < 4; ++j) o8[64 * j] = (unsigned long long)pk2(v[j].x * rstd, v[j].y * rstd) | ((unsigned long long)pk2(v[j].z * rstd, v[j].w * rstd) << 32);
    }
    if (gw < 16) { float* lb = (float*)(p.ws + WS_LB); const int c = gw * 64 + lane; lb[c] = 1.f / (1.f + __expf(p.lbp[D + c] - p.lbp[c])); }
}

__device__ __forceinline__ void aux_meta_gemm1(const P& p, int gw, int NGW, int lane) {
    const bf16* xb = (const bf16*)(p.ws + WS_XB); const bf16* win = (const bf16*)(p.ws + WS_WIN); const float* lbp = (const float*)(p.ws + WS_LB);
    const int fr = lane & 15, fq = lane >> 4;
    for (int task = gw; task < 384; task += NGW) {
        const int type = task >> 6, cb = (task & 63) * 16;
        int rowA, rowB = 0;
        if (type <= 2) rowA = type * 1024 + cb; else { rowA = 3072 + (type - 3) * 2048 + (cb >> 7) * 256 + (cb & 127); rowB = rowA + 128; }
        const bf16* ap = xb + (size_t)(M + fr) * D + 8 * fq;
        const bf16* b0p = win + (size_t)(rowA + fr) * D + 8 * fq;
        const bf16* b1p = win + (size_t)(rowB + fr) * D + 8 * fq;
        pg8::f32x4 acc0 = {0.f, 0.f, 0.f, 0.f}, acc1 = {0.f, 0.f, 0.f, 0.f};
#pragma unroll 4
        for (int kk = 0; kk < D / 32; ++kk) {
            const bf16x8 a = *(const bf16x8*)(ap + kk * 32), b0 = *(const bf16x8*)(b0p + kk * 32);
            acc0 = __builtin_amdgcn_mfma_f32_16x16x32_bf16(a, b0, acc0, 0, 0, 0);
            if (type >= 3) { const bf16x8 b1 = *(const bf16x8*)(b1p + kk * 32); acc1 = __builtin_amdgcn_mfma_f32_16x16x32_bf16(a, b1, acc1, 0, 0, 0); }
        }
        const int ch = cb + fr; const float lb = lbp[ch];
        bf16* dst = (bf16*)(p.ws + WS_QS + (size_t)(type == 0 ? 0 : type - 1) * (33 * MiB));
#pragma unroll
        for (int e = 0; e < 4; ++e) { const int mrow = 4 * fq + e; const float o = epi1_math(type, acc0[e], acc1[e], lb);
            if (type == 1) ((float*)(p.ws + WS_LOGFM))[(size_t)mrow * D + ch] = o; else dst[(size_t)(M + mrow) * D + ch] = (bf16)f2bf(o); }
    }
}

__device__ __forceinline__ const float* logfrow(const P& p, int r) { return r < M ? p.out + (size_t)r * D : (const float*)(p.ws + WS_LOGFM) + (size_t)(r - M) * D; }
__device__ __forceinline__ int prevrow(int r, int j) {
    if (r < M) { const int t = r % SEQ; return t >= j ? r - j : M + NMETA + (t - j); }
    const int m = r - M; return m >= j ? r - j : -1;
}
__device__ __forceinline__ void naive_hgrn(const P& p, int gw, int lane) {
    if (gw >= BATCH * NH * DH) return;
    const int b = gw / (NH * DH), h = (gw / DH) % NH, vc = gw % DH;
    const bf16* qs = (const bf16*)(p.ws + WS_QS); const bf16* vb = (const bf16*)(p.ws + WS_V); bf16* ob = (bf16*)(p.ws + WS_O);
    float S0 = 0.f, S1 = 0.f;
    for (int t0 = 0; t0 < NMETA + SEQ; t0 += 4) {
        float lf0[4], lf1[4], q0[4], q1[4], vv[4]; int rr[4];
#pragma unroll
        for (int u = 0; u < 4; ++u) {
            const int t = t0 + u; const int r = t < NMETA ? M + t : b * SEQ + (t - NMETA); rr[u] = r;
            const size_t o = (size_t)r * D + h * DH; const float* lf = logfrow(p, r) + h * DH;
            lf0[u] = lf[lane]; lf1[u] = lf[64 + lane]; q0[u] = bf2f(qs[o + lane]); q1[u] = bf2f(qs[o + 64 + lane]); vv[u] = bf2f(vb[o + vc]);
        }
#pragma unroll
        for (int u = 0; u < 4; ++u) {
            const float f0 = __expf(lf0[u]), f1 = __expf(lf1[u]);
            S0 = f0 * S0 + (1.f - f0) * vv[u]; S1 = f1 * S1 + (1.f - f1) * vv[u];
            const float o = wave_sum(q0[u] * S0 + q1[u] * S1);
            if (lane == 0 && (rr[u] < M || b == 0)) ob[(size_t)rr[u] * D + h * DH + vc] = (bf16)f2bf(o);
        }
    }
}
__device__ __forceinline__ void naive_merge(const P& p, int gw, int NGW, int lane) {
    const bf16* ob = (const bf16*)(p.ws + WS_O); const bf16* ga = (const bf16*)(p.ws + WS_GA); const bf16* bg = (const bf16*)(p.ws + WS_BG); const bf16* cx = (const bf16*)(p.ws + WS_CX);
    bf16* merged = (bf16*)(p.ws + WS_MERGED);
    for (int it = gw; it < MR * NH; it += NGW) {
        const int r = it / NH, h = it % NH, c0 = h * DH + lane, c1 = c0 + 64;
        const float o0 = bf2f(ob[(size_t)r * D + c0]), o1 = bf2f(ob[(size_t)r * D + c1]);
        const float rs = 1.f / sqrtf(wave_sum(o0 * o0 + o1 * o1) * (1.f / DH) + EPS);
        const int r1 = prevrow(r, 1), r2 = prevrow(r, 2);
#pragma unroll
        for (int e = 0; e < 2; ++e) {
            const int c = e ? c1 : c0; const float o = e ? o1 : o0;
            const float ya = o * rs * p.hnw[c & (DH - 1)] * bf2f(ga[(size_t)r * D + c]);
            const float x0 = bf2f(cx[(size_t)r * D + c]), x1 = r1 >= 0 ? bf2f(cx[(size_t)r1 * D + c]) : 0.f, x2 = r2 >= 0 ? bf2f(cx[(size_t)r2 * D + c]) : 0.f;
            const float conv = p.cw[c] * x2 + p.cw[D + c] * x1 + p.cw[2 * D + c] * x0;
            merged[(size_t)r * D + c] = (bf16)f2bf(ya + bf2f(bg[(size_t)r * D + c]) * conv);
        }
    }
}
__device__ __forceinline__ const float* h1row(const P& p, int r) { return r < M ? p.out + (size_t)r * D : (const float*)(p.ws + WS_H1M) + (size_t)(r - M) * D; }
__device__ __forceinline__ void naive_gemm2(const P& p, int vbx, int vby, int t256) {
    const int c = vbx * 256 + t256, r0 = vby * 4;
    const bf16* merged = (const bf16*)(p.ws + WS_MERGED);
    float acc[4] = {0.f, 0.f, 0.f, 0.f};
    for (int k = 0; k < D; ++k) { const float w = p.w_out[(size_t)k * D + c];
#pragma unroll
        for (int i = 0; i < 4; ++i) acc[i] += bf2f(merged[(size_t)(r0 + i) * D + k]) * w; }
#pragma unroll
    for (int i = 0; i < 4; ++i) { const int r = r0 + i; const float v = h0row(p, r)[c] + acc[i];
        if (r < M) p.out[(size_t)r * D + c] = v; else ((float*)(p.ws + WS_H1M))[(size_t)(r - M) * D + c] = v; }
}
__device__ __forceinline__ void naive_rstd2(const P& p, int gw, int NGW, int lane) {
    for (int r = gw; r < MR; r += NGW) { const float* xr = h1row(p, r); float s = 0.f;
        for (int k = lane; k < D; k += 64) { const float v = xr[k]; s += v * v; }
        s = wave_sum(s);
        if (lane == 0) ((float*)(p.ws + WS_RSTD2))[r] = 1.f / sqrtf(s * (1.f / D) + EPS); }
}
__device__ __forceinline__ void naive_gemm3(const P& p, int vbx, int vby, int t256) {
    const int c = vbx * 256 + t256, r0 = vby * 4;
    const float* rstd = (const float*)(p.ws + WS_RSTD2);
    int rows[6]; rows[0] = prevrow(r0, 2); rows[1] = prevrow(r0, 1);
#pragma unroll
    for (int i = 0; i < 4; ++i) rows[2 + i] = r0 + i;
    const float* hr[6];
#pragma unroll
    for (int i = 0; i < 6; ++i) hr[i] = h1row(p, rows[i]);
    float aa[6], vv[4];
#pragma unroll
    for (int i = 0; i < 6; ++i) aa[i] = 0.f;
#pragma unroll
    for (int i = 0; i < 4; ++i) vv[i] = 0.f;
    for (int k = 0; k < D; ++k) {
        const float nw = p.fnw[k]; const float wa = p.w_up[(size_t)k * NUP + c] * nw, wv = p.w_up[(size_t)k * NUP + DFF + c] * nw;
#pragma unroll
        for (int i = 0; i < 6; ++i) { const float hv = hr[i][k]; aa[i] += hv * wa; if (i >= 2) vv[i - 2] += hv * wv; }
    }
#pragma unroll
    for (int i = 0; i < 6; ++i) aa[i] *= rstd[rows[i]];
    const float w0 = p.fcw[c], w1 = p.fcw[DFF + c], w2 = p.fcw[2 * DFF + c], bb = p.fcb[c];
    bf16* g = (bf16*)(p.ws + WS_G);
#pragma unroll
    for (int i = 0; i < 4; ++i) { const float a = w0 * aa[i] + w1 * aa[i + 1] + w2 * aa[i + 2] + bb; const float val = vv[i] * rstd[r0 + i];
        g[(size_t)(r0 + i) * DFF + c] = (bf16)f2bf(a * sigm(a) * val); }
}
__device__ __forceinline__ void naive_gemm4(const P& p, int vbx, int vby, int t256) {
    const int c = vbx * 256 + t256, r0 = vby * 4;
    const bf16* g = (const bf16*)(p.ws + WS_G);
    float acc[4] = {0.f, 0.f, 0.f, 0.f};
    for (int k = 0; k < DFF; ++k) { const float w = p.w_down[(size_t)k * D + c];
#pragma unroll
        for (int i = 0; i < 4; ++i) acc[i] += bf2f(g[(size_t)(r0 + i) * DFF + k]) * w; }
#pragma unroll
    for (int i = 0; i < 4; ++i) p.out[(size_t)(r0 + i) * D + c] += acc[i];
}
__device__ __forceinline__ void naive_final(const P& p, int gw, int NGW, int lane) {
    for (int r = gw; r < M; r += NGW) {
        float* xr = p.out + (size_t)r * D; float v[16]; float s = 0.f;
#pragma unroll
        for (int j = 0; j < 16; ++j) { v[j] = xr[lane + 64 * j]; s += v[j] * v[j]; }
        s = wave_sum(s); const float rs = 1.f / sqrtf(s * (1.f / D) + EPS);
#pragma unroll
        for (int j = 0; j < 16; ++j) xr[lane + 64 * j] = v[j] * rs * p.finw[lane + 64 * j];
    }
}

constexpr int H1B_ROWS = 8384;
constexpr size_t WS_H1B = WS_XB;
struct Epi2 {
    static constexpr bool PERM = false, AFTER_DRAIN = false;
    const float* x; float* out; bf16* h1b; float* rss;
    __device__ __forceinline__ void operator()(const pg8::f32x4 (&acc)[2][2][4][2], const pg8::Unit& u, int wr, int wc, int fr, int fq) const {
        const int col0 = u.pn * 256 + wc * 32 + 4 * fq;
#pragma unroll
        for (int ai = 0; ai < 2; ++ai)
#pragma unroll
            for (int m = 0; m < 4; ++m) {
                const int r = u.pm * 256 + ai * 128 + wr * 64 + m * 16 + fr; const size_t off = (size_t)r * D + col0;
                bf16* hb = h1b + ((size_t)((r >> 13) * H1B_ROWS + 2 + (r & (SEQ - 1)))) * D + col0; float ss = 0.f;
#pragma unroll
                for (int bj = 0; bj < 2; ++bj)
#pragma unroll
                    for (int n = 0; n < 2; ++n) { const pg8::f32x4 h = *(const pg8::f32x4*)(x + off + bj * 128 + n * 16) + acc[ai][bj][m][n];
                        *(pg8::f32x4*)(out + off + bj * 128 + n * 16) = h; ss += (h[0] * h[0] + h[1] * h[1]) + (h[2] * h[2] + h[3] * h[3]);
                        uint2 w; w.x = pg8::cvt_pk_bf16(h[0], h[1]); w.y = pg8::cvt_pk_bf16(h[2], h[3]); *(uint2*)(hb + bj * 128 + n * 16) = w; }
                ss += __shfl_xor(ss, 16); ss += __shfl_xor(ss, 32);
                if (fq == 0) atomicAdd(rss + r, ss);
            }
    }
};
__device__ __forceinline__ void aux_meta_gemm2(const P& p, const bf16* merged, int gw, int NGW, int lane) {
    const bf16* wout = (const bf16*)(p.ws + WS_WOUT); bf16* h1b = (bf16*)(p.ws + WS_H1B); float* rss = (float*)(p.ws + WS_RSS2); float* h1m = (float*)(p.ws + WS_H1M);
    const int fr = lane & 15, fq = lane >> 4;
    for (int task = gw; task < D / 16; task += NGW) {
        const int cb = task * 16;
        const bf16* ap = merged + (size_t)(M + fr) * D + 8 * fq; const bf16* bp = wout + (size_t)(cb + fr) * D + 8 * fq;
        pg8::f32x4 acc = {0.f, 0.f, 0.f, 0.f};
#pragma unroll 4
        for (int kk = 0; kk < D / 32; ++kk) acc = __builtin_amdgcn_mfma_f32_16x16x32_bf16(*(const bf16x8*)(ap + kk * 32), *(const bf16x8*)(bp + kk * 32), acc, 0, 0, 0);
        const int ch = cb + fr;
#pragma unroll
        for (int e = 0; e < 4; ++e) { const int mrow = 4 * fq + e; const float h = p.meta[(size_t)mrow * D + ch] + acc[e];
            h1m[(size_t)mrow * D + ch] = h;
            if (mrow >= 14) { const bf16 hb = (bf16)f2bf(h); h1b[(size_t)(mrow - 14) * D + ch] = hb; h1b[((size_t)H1B_ROWS + (mrow - 14)) * D + ch] = hb; }
            float ss = h * h; ss += __shfl_xor(ss, 1); ss += __shfl_xor(ss, 2); ss += __shfl_xor(ss, 4); ss += __shfl_xor(ss, 8);
            if (fr == 0) atomicAdd(rss + M + mrow, ss); }
    }
}

constexpr int G3_TILES_PER_BATCH = 33, G3_STEP = 254, XCH_OFF = LDSCTL_OFF + 1024;
struct Sched3 : pg8::StaticOrder {
    __device__ __forceinline__ size_t a_off(const pg8::Unit& u, size_t  ) const { const int b = u.pm / G3_TILES_PER_BATCH, pmb = u.pm % G3_TILES_PER_BATCH; return (size_t)(b * H1B_ROWS + G3_STEP * pmb) * D * 2; }
};
__device__ __forceinline__ float dpp_ror1(float v) { return __builtin_bit_cast(float, __builtin_amdgcn_mov_dpp(__builtin_bit_cast(int, v), 0x121, 0xf, 0xf, false)); }
__device__ __forceinline__ float dpp_ror2(float v) { return __builtin_bit_cast(float, __builtin_amdgcn_mov_dpp(__builtin_bit_cast(int, v), 0x122, 0xf, 0xf, false)); }
struct Epi3 {
    static constexpr bool PERM = true, AFTER_DRAIN = false;
    bf16* g; const float* rss; const float* fcw; const float* fcb; LAS float* xch;
    __device__ __forceinline__ void operator()(const pg8::f32x4 (&acc)[2][2][4][2], const pg8::Unit& u, int wr, int wc, int fr, int fq) const {
        const int b = u.pm / G3_TILES_PER_BATCH, pmb = u.pm % G3_TILES_PER_BATCH, t0 = G3_STEP * pmb - 2;
        const int chl = wc * 32 + 8 * fq, ch = u.pn * 128 + chl;
        float w0[8], w1[8], w2[8], bb[8];
#pragma unroll
        for (int e = 0; e < 8; ++e) { w0[e] = fcw[ch + e]; w1[e] = fcw[DFF + ch + e]; w2[e] = fcw[2 * DFF + ch + e]; bb[e] = fcb[ch + e]; }
        float rs[2][4];
#pragma unroll
        for (int ai = 0; ai < 2; ++ai)
#pragma unroll
            for (int m = 0; m < 4; ++m) { const int t = t0 + ai * 128 + wr * 64 + m * 16 + fr; float s = 0.f;
                if (t < SEQ) { const int ri = t >= 0 ? b * SEQ + t : M + NMETA + t; s = 1.f / sqrtf(rss[ri] * (1.f / D) + EPS); }
                rs[ai][m] = s; }
        if (fr >= 14) {
#pragma unroll
            for (int ai = 0; ai < 2; ++ai) { LAS float* dst = xch + ((2 * ai + wr) * 2 + (fr - 14)) * 128 + chl;
#pragma unroll
                for (int e = 0; e < 8; ++e) dst[e] = acc[ai][0][3][e >> 2][e & 3] * rs[ai][3]; }
        }
        asm volatile("s_waitcnt lgkmcnt(0)" ::: "memory"); __builtin_amdgcn_s_barrier(); asm volatile("" ::: "memory");
#pragma unroll
        for (int ai = 0; ai < 2; ++ai) {
            const int q = 2 * ai + wr; float prev[8];
#pragma unroll
            for (int e = 0; e < 8; ++e) prev[e] = 0.f;
            if (q >= 1 && fr >= 14) { const LAS float* src = xch + ((q - 1) * 2 + (fr - 14)) * 128 + chl;
#pragma unroll
                for (int e = 0; e < 8; ++e) prev[e] = src[e]; }
#pragma unroll
            for (int m = 0; m < 4; ++m) {
                const int i = ai * 128 + wr * 64 + m * 16 + fr, t = t0 + i; float cur[8], o[8];
#pragma unroll
                for (int e = 0; e < 8; ++e) cur[e] = acc[ai][0][m][e >> 2][e & 3] * rs[ai][m];
#pragma unroll
                for (int e = 0; e < 8; ++e) {
                    const float c1 = dpp_ror1(cur[e]), c2 = dpp_ror2(cur[e]), q1 = dpp_ror1(prev[e]), q2 = dpp_ror2(prev[e]);
                    const float p1 = fr >= 1 ? c1 : q1, p2 = fr >= 2 ? c2 : q2;
                    const float a = w0[e] * p2 + w1[e] * p1 + w2[e] * cur[e] + bb[e];
                    o[e] = a * sigm(a) * (acc[ai][1][m][e >> 2][e & 3] * rs[ai][m]);
                }
                if (i >= 2 && t < SEQ) { pg8::u32x4 w; w.x = pg8::cvt_pk_bf16(o[0], o[1]); w.y = pg8::cvt_pk_bf16(o[2], o[3]); w.z = pg8::cvt_pk_bf16(o[4], o[5]); w.w = pg8::cvt_pk_bf16(o[6], o[7]);
                    *(pg8::u32x4*)(g + (size_t)(b * SEQ + t) * DFF + ch) = w; }
#pragma unroll
                for (int e = 0; e < 8; ++e) prev[e] = cur[e];
            }
        }
    }
};

struct Epi4 {
    static constexpr bool PERM = false, AFTER_DRAIN = false;
    float* out; float* rss;
    __device__ __forceinline__ void operator()(const pg8::f32x4 (&acc)[2][2][4][2], const pg8::Unit& u, int wr, int wc, int fr, int fq) const {
        const int col0 = u.pn * 256 + wc * 32 + 4 * fq;
#pragma unroll
        for (int ai = 0; ai < 2; ++ai)
#pragma unroll
            for (int m = 0; m < 4; ++m) {
                const int r = u.pm * 256 + ai * 128 + wr * 64 + m * 16 + fr; const size_t off = (size_t)r * D + col0; float ss = 0.f;
#pragma unroll
                for (int bj = 0; bj < 2; ++bj)
#pragma unroll
                    for (int n = 0; n < 2; ++n) { const pg8::f32x4 h = *(const pg8::f32x4*)(out + off + bj * 128 + n * 16) + acc[ai][bj][m][n];
                        *(pg8::f32x4*)(out + off + bj * 128 + n * 16) = h; ss += (h[0] * h[0] + h[1] * h[1]) + (h[2] * h[2] + h[3] * h[3]); }
                ss += __shfl_xor(ss, 16); ss += __shfl_xor(ss, 32);
                if (fq == 0) atomicAdd(rss + r, ss);
            }
    }
};
__device__ __forceinline__ void final_norm(const P& p, int gw, int NGW, int lane) {
    const float* rss = (const float*)(p.ws + WS_RSS3);
    f32x4 wv[4];
#pragma unroll
    for (int j = 0; j < 4; ++j) wv[j] = ((const f32x4*)p.finw)[lane + 64 * j];
    for (int r = gw; r < M; r += NGW) {
        const float rs = 1.f / sqrtf(rss[r] * (1.f / D) + EPS); f32x4* xr = (f32x4*)(p.out + (size_t)r * D) + lane;
#pragma unroll
        for (int j = 0; j < 4; ++j) xr[64 * j] = xr[64 * j] * rs * wv[j];
    }
}
#define XB_TMO      128
#define XB_XCNT(j)  (256  + 64 * (j))
#define XB_XSUB(j)  (1280 + 64 * (j))
#define XB_XGEN(j)  (2304 + 64 * (j))
#define XB_TOP      3328
#define XB_TOPGEN   3392
#define XCD_BAR_WORDS 3456
#define XB_SPIN_CAP (1u << 18)

__device__ __forceinline__ unsigned xb_ld(unsigned* p)              { return __hip_atomic_load(p, __ATOMIC_RELAXED, __HIP_MEMORY_SCOPE_AGENT); }
__device__ __forceinline__ unsigned xb_add(unsigned* p, unsigned v) { return __hip_atomic_fetch_add(p, v, __ATOMIC_RELAXED, __HIP_MEMORY_SCOPE_AGENT); }
__device__ __forceinline__ unsigned xb_xcc_id() { return (unsigned)__builtin_amdgcn_s_getreg((3 << 11) | 20) & 0xFu; }
#define XB_SPIN(cond, bar) do { unsigned _sp = 0; while (cond) { __builtin_amdgcn_s_sleep(1); \
    if ((++_sp & 255u) == 0u) { if (xb_ld(&(bar)[XB_TMO])) break; if (_sp > XB_SPIN_CAP) { atomicAdd(&(bar)[XB_TMO], 1u); break; } } } } while (0)

struct XcdBarrier {
    unsigned* bar; unsigned x;
    volatile LAS unsigned* st;
};

__device__ __forceinline__ XcdBarrier xcd_barrier_post(unsigned* bar, volatile LAS unsigned* st) {
    XcdBarrier b; b.bar = bar; b.x = xb_xcc_id(); b.st = st;
    if (threadIdx.x == 0) (void)xb_add(&bar[XB_XCNT(b.x)], 1u);
    return b;
}
__device__ __forceinline__ void xcd_barrier_complete(unsigned* bar, unsigned x, unsigned& nloc, unsigned& nx) {
    const unsigned G = gridDim.x * gridDim.y * gridDim.z;
    unsigned sum, cnt, mine, sp = 0u;
    for (;;) {
        sum = 0u; cnt = 0u; mine = 0u;
#pragma unroll
        for (unsigned j = 0; j < 16; ++j) { const unsigned c = xb_ld(&bar[XB_XCNT(j)]); sum += c; cnt += (c > 0u) ? 1u : 0u; mine = (j == x) ? c : mine; }
        if (sum == G) break;
        __builtin_amdgcn_s_sleep(1);
        if ((++sp & 255u) == 0u) { if (xb_ld(&bar[XB_TMO])) break; if (sp > XB_SPIN_CAP) { atomicAdd(&bar[XB_TMO], 1u); break; } }
    }
    nloc = mine > 0u ? mine : 1u; nx = cnt > 0u ? cnt : 1u;
}

__device__ __forceinline__ void xcd_barrier(const XcdBarrier& b) {
    asm volatile("s_waitcnt vmcnt(0)" ::: "memory");
    __syncthreads();
    if (threadIdx.x == 0) {
        unsigned* bar = b.bar;
        __builtin_amdgcn_s_waitcnt(0);
        unsigned nloc = b.st[0], nx = b.st[1];
        if (nloc == 0u) { xcd_barrier_complete(bar, b.x, nloc, nx); b.st[0] = nloc; b.st[1] = nx; }
        const unsigned old = xb_add(&bar[XB_XSUB(b.x)], 1u);
        const unsigned gen = old / nloc;
        if (old + 1u == (gen + 1u) * nloc) {
            __builtin_amdgcn_fence(__ATOMIC_RELEASE, "agent");
            asm volatile("s_waitcnt vmcnt(0)" ::: "memory");
            const unsigned og = xb_add(&bar[XB_TOP], 1u);
            const unsigned tg = og / nx;
            if (og + 1u == (tg + 1u) * nx) xb_add(&bar[XB_TOPGEN], 1u);
            else XB_SPIN(xb_ld(&bar[XB_TOPGEN]) == tg, bar);
            __builtin_amdgcn_fence(__ATOMIC_ACQUIRE, "agent");
            xb_add(&bar[XB_XGEN(b.x)], 1u);
            asm volatile("s_waitcnt vmcnt(0)" ::: "memory");
        } else {
            XB_SPIN(xb_ld(&bar[XB_XGEN(b.x)]) == gen, bar);
            __builtin_amdgcn_fence(__ATOMIC_ACQUIRE, "agent");
            asm volatile("s_waitcnt vmcnt(0)" ::: "memory");
        }
    }
    __syncthreads();
}

struct Args { P p; int ph_lo, ph_hi; };
__global__ void __launch_bounds__(NWAVES * 64, 2) fwd_mega(Args args) {
    extern __shared__ __attribute__((aligned(16))) unsigned char lds_raw[];
    LAS unsigned char* lds = (LAS unsigned char*)lds_raw;
    volatile LAS unsigned* MISC = (volatile LAS unsigned*)(lds + MISC_OFF);
    const P& p = args.p;
    const int tid = threadIdx.x, lane = tid & 63, wave = __builtin_amdgcn_readfirstlane(tid >> 6);
    const int G = gridDim.x, bx = blockIdx.x, vcu = (G % 8 == 0) ? (bx % 8) * (G / 8) + bx / 8 : bx;
    const int gw = vcu * NWAVES + wave, NGW = G * NWAVES;
    gu32* ctl = (gu32*)(p.ws + WS_CTL);
    for (int u = tid; u < (LDS_BYTES - LDSCTL_OFF) / 4; u += NWAVES * 64) ((LAS unsigned*)(lds + LDSCTL_OFF))[u] = 0u;
    __syncthreads();
    XcdBarrier bar = xcd_barrier_post((unsigned*)(ctl + CW_BAR), MISC + 8);
    const int lo = args.ph_lo, hi = args.ph_hi;
#define IN(k) (lo <= (k) && (k) < hi)
#define SEAM(k) do { if (IN(k) && IN((k) + 1)) xcd_barrier(bar); } while (0)

    if (IN(0)) { p0_prologue(p, lds, vcu, G, wave, lane); }
    SEAM(0);
    if (IN(1)) {
        pg8::Gemm g{(const bf16*)(p.ws + WS_XB), (const bf16*)(p.ws + WS_WIN), M, NIN, D}; pg8::StaticOrder S; S.init(M, NIN, G, bx);
        Epi1 E{p.ws, p.out, (const float*)(p.ws + WS_LB)};
        pg8::gemm_phase<Epi1, pg8::StaticOrder, true, true>(lds, g, S, E);
        aux_meta_gemm1(p, gw, NGW, lane);
    }
    SEAM(1);
    if (IN(2)) { naive_hgrn(p, gw, lane); }
    SEAM(2);
    if (IN(3)) { naive_merge(p, gw, NGW, lane); }
    SEAM(3);
    if (IN(4)) {
        const bf16* merged = (const bf16*)(p.ws + WS_MERGED);
        aux_meta_gemm2(p, merged, gw, NGW, lane);
        pg8::Gemm g{merged, (const bf16*)(p.ws + WS_WOUT), M, D, D}; pg8::StaticOrder S; S.init(M, D, G, bx);
        Epi2 E{p.x, p.out, (bf16*)(p.ws + WS_H1B), (float*)(p.ws + WS_RSS2)};
        pg8::gemm_phase<Epi2, pg8::StaticOrder, true, true>(lds, g, S, E);
    }
    SEAM(4);
    if (IN(5)) {
        pg8::Gemm g{(const bf16*)(p.ws + WS_H1B), (const bf16*)(p.ws + WS_WUP), 2 * G3_TILES_PER_BATCH * 256, NUP, D}; Sched3 S; S.init(2 * G3_TILES_PER_BATCH * 256, NUP, G, bx);
        Epi3 E{(bf16*)(p.ws + WS_G), (const float*)(p.ws + WS_RSS2), p.fcw, p.fcb, (LAS float*)(lds + XCH_OFF)};
        pg8::gemm_phase<Epi3, Sched3, true, true>(lds, g, S, E);
    }
    SEAM(5);
    if (IN(6)) {
        pg8::Gemm g{(const bf16*)(p.ws + WS_G), (const bf16*)(p.ws + WS_WDN), M, D, DFF}; pg8::StaticOrder S; S.init(M, D, G, bx);
        Epi4 E{p.out, (float*)(p.ws + WS_RSS3)};
        pg8::gemm_phase<Epi4, pg8::StaticOrder, true, true>(lds, g, S, E);
    }
    SEAM(6);
    if (IN(7)) { final_norm(p, gw, NGW, lane); }
#undef IN
#undef SEAM
}

constexpr int N_PHASES = 8;
#ifndef MK_N_LAUNCHES
#define MK_N_LAUNCHES 1
#endif
extern "C" void kernel_launch(void* const* d_in, const int* in_sizes, int n_in, void* d_out, int out_size, void* d_ws, size_t ws_size, hipStream_t stream) {
    static int grid = 0;
    if (grid == 0) {
        if (n_in != 14 || in_sizes[0] != M * D || out_size != M * D || ws_size < WS_END) { fprintf(stderr, "kernel_launch: unexpected shapes (n_in %d, in0 %d, out %d, ws %zu)\n", n_in, n_in > 0 ? in_sizes[0] : -1, out_size, ws_size); grid = -1; return; }
        int dev = 0, cus = 0, per_cu = 0;
        if (hipGetDevice(&dev) != hipSuccess || hipDeviceGetAttribute(&cus, hipDeviceAttributeMultiprocessorCount, dev) != hipSuccess) { grid = -1; return; }
        if (hipFuncSetAttribute((const void*)fwd_mega, hipFuncAttributeMaxDynamicSharedMemorySize, LDS_BYTES) != hipSuccess) { fprintf(stderr, "kernel_launch: hipFuncSetAttribute failed\n"); grid = -1; return; }
        if (hipOccupancyMaxActiveBlocksPerMultiprocessor(&per_cu, (const void*)fwd_mega, NWAVES * 64, LDS_BYTES) != hipSuccess || per_cu < 1) { fprintf(stderr, "kernel_launch: occupancy query says %d blocks per CU\n", per_cu); per_cu = 1; }
        (void)hipGetLastError();
        grid = cus;
    }
    if (grid < 0) return;
    if (hipMemsetAsync((char*)d_ws + WS_CTL, 0, CTL_ZERO_BYTES, stream) != hipSuccess) { fprintf(stderr, "kernel_launch: memset failed\n"); return; }
    Args a{};
    const float** f = (const float**)&a.p;
    for (int i = 0; i < 14; ++i) f[i] = (const float*)d_in[i];
    a.p.out = (float*)d_out; a.p.ws = (unsigned char*)d_ws;
    if (MK_N_LAUNCHES == 1) { a.ph_lo = 0; a.ph_hi = N_PHASES; hipLaunchKernelGGL(fwd_mega, dim3(grid), dim3(NWAVES * 64), LDS_BYTES, stream, a); }
    else for (int li = 0; li < N_PHASES; ++li) { a.ph_lo = li; a.ph_hi = li + 1; hipLaunchKernelGGL(fwd_mega, dim3(grid), dim3(NWAVES * 64), LDS_BYTES, stream, a); }
}
```

```cpp
#include <hip/hip_runtime.h>
#include <cstdint>
#include <cstdio>
namespace pg8 {
#define PG8_LAS __attribute__((address_space(3)))
typedef unsigned short bf16_t;
typedef short bf16x8 __attribute__((ext_vector_type(8)));
typedef float f32x4 __attribute__((ext_vector_type(4)));
typedef unsigned u32x4 __attribute__((ext_vector_type(4)));
constexpr int BM = 256, BK = 64, HALF = 128, HTB = HALF * BK * 2  , STAGE_BYTES = 8 * HTB, NXCD = 8, WGM = 8;

__host__ __device__ __forceinline__ int lds_byte(int r, int c) { const int st = (r >> 4) * 2 + (c >> 5), rr = r & 15, cc = c & 31, ob = rr * 64 + cc * 2; return st * 1024 + (ob ^ (((ob >> 9) & 1) << 5)); }
__host__ __device__ __forceinline__ void stage_rc(int b, int& R, int& C) { const int st = b / 1024, sb = b % 1024, swz = sb ^ (((sb >> 9) & 1) << 5); R = (st >> 1) * 16 + swz / 64; C = (st & 1) * 32 + (swz % 64) / 2; }
__host__ __device__ __forceinline__ int perm32(int rho) { const int n = rho >> 4, i = rho & 15; return 8 * (i >> 2) + 4 * n + (i & 3); }

struct Unit { int pm, pn; };
struct Gemm { const bf16_t* A; const bf16_t* Bt; int M, N, K; };

struct StaticOrder {
    int nM, nN, nwg, G, c;
    __host__ __device__ void init(int M, int N, int G_, int c_) { nM = M / BM; nN = N / BM; nwg = nM * nN; G = G_; c = c_; }
    __host__ __device__ bool next(int i, Unit& u) const {
        const long L = (long)i * G + c; if (L >= nwg) return false;
        int wgid = (int)L; { const int q = nwg / NXCD, r = nwg % NXCD, xcd = wgid % NXCD, off = wgid / NXCD; wgid = (xcd < r ? xcd * (q + 1) : r * (q + 1) + (xcd - r) * q) + off; }
        const int nig = WGM * nN, gid = wgid / nig, fm = gid * WGM, gsz = (nM - fm) < WGM ? (nM - fm) : WGM;
        u.pm = fm + ((wgid % nig) % gsz); u.pn = (wgid % nig) / gsz; return true;
    }
    __device__ __forceinline__ size_t a_off(const Unit& u, size_t tstep) const { return (size_t)u.pm * tstep; }
    __device__ __forceinline__ void a_ready(const Unit&) const {}
    __device__ __forceinline__ void done(const Unit&) const {}
};

__device__ __forceinline__ unsigned cvt_pk_bf16(float lo, float hi) { unsigned r; asm volatile("v_cvt_pk_bf16_f32 %0, %1, %2" : "=v"(r) : "v"(lo), "v"(hi)); return r; }
template <class Epi, class Sched, bool ALIGN_EPI = false, bool SP2 = false>
__device__ __forceinline__ void gemm_phase(PG8_LAS unsigned char* lds, const Gemm g, const Sched& S, const Epi& E) {
    const int tid = threadIdx.x, wid = __builtin_amdgcn_readfirstlane(tid >> 6), lane = tid & 63, wr = wid >> 2, wc = wid & 3, fr = lane & 15, fq = lane >> 4;
    const int K = g.K, nt = K / BK;
    unsigned voffA[2], voffB[2];
#pragma unroll
    for (int i = 0; i < 2; ++i) { int R, C; stage_rc(tid * 16 + i * 8192, R, C); const int Rb = Epi::PERM ? ((R & ~31) + perm32(R & 31)) : R;
        voffA[i] = (unsigned)(R * K + C) * 2u; voffB[i] = (unsigned)(Rb * K + C) * 2u; }
    const size_t kstep = (size_t)(BK * 2);
    const size_t hstep = (size_t)HALF * K * 2;
    const size_t tstep = 2 * hstep;
    const unsigned ldsw = (unsigned)wid * 1024u;
    const int aoff = lds_byte(wr * 64 + fr, fq * 8), boff = lds_byte(wc * 32 + fr, fq * 8);
#define PG8_SA(b, h) (((b) * 2 + (h)) * HTB)
#define PG8_SB(b, h) ((4 + (b) * 2 + (h)) * HTB)
#define PG8_STAGE(bufoff, gbase, voff) do { _Pragma("unroll") for (int _i = 0; _i < 2; ++_i) \
        __builtin_amdgcn_global_load_lds((const unsigned*)((const char*)(gbase) + (voff)[_i]), (PG8_LAS unsigned*)(lds + (bufoff) + ldsw + _i * 8192), 16, 0, 0); } while (0)
#define PG8_LDA(dst, b, h) do { _Pragma("unroll") for (int m = 0; m < 4; ++m) _Pragma("unroll") for (int k = 0; k < 2; ++k) dst[m][k] = *(const PG8_LAS bf16x8*)(lds + PG8_SA(b, h) + aoff + m * 2048 + k * 1024); } while (0)
#define PG8_LDB(dst, b, h) do { _Pragma("unroll") for (int n = 0; n < 2; ++n) _Pragma("unroll") for (int k = 0; k < 2; ++k) dst[n][k] = *(const PG8_LAS bf16x8*)(lds + PG8_SB(b, h) + boff + n * 2048 + k * 1024); } while (0)
#define PG8_MMA(ai, bj, At, Bt) do { __builtin_amdgcn_s_setprio(1); _Pragma("unroll") for (int m = 0; m < 4; ++m) _Pragma("unroll") for (int n = 0; n < 2; ++n) _Pragma("unroll") for (int k = 0; k < 2; ++k) \
        acc[ai][bj][m][n] = __builtin_amdgcn_mfma_f32_16x16x32_bf16(Bt[n][k], At[m][k], acc[ai][bj][m][n], 0, 0, 0); __builtin_amdgcn_s_setprio(0); } while (0)
#define PG8_WAIT_V(n) asm volatile("s_waitcnt vmcnt(" #n ")" ::: "memory")
#define PG8_WAIT_L(n) asm volatile("s_waitcnt lgkmcnt(" #n ")" ::: "memory")
#define PG8_BAR __builtin_amdgcn_s_barrier()
#define PG8_SCHED __builtin_amdgcn_sched_barrier(0)
    Unit cur, nxt; int ui = 0;
    if (!S.next(0, cur)) return;
    f32x4 acc[2][2][4][2];
#pragma unroll
    for (int a = 0; a < 2; ++a)
#pragma unroll
        for (int b = 0; b < 2; ++b)
#pragma unroll
            for (int m = 0; m < 4; ++m)
#pragma unroll
                for (int n = 0; n < 2; ++n) acc[a][b][m][n] = (f32x4){0.f, 0.f, 0.f, 0.f};
    bf16x8 At[4][2], B0[2][2], B1[2][2];
    const char* cA = (const char*)g.A + S.a_off(cur, tstep); const char* cB = (const char*)g.Bt + (size_t)cur.pn * tstep;
    S.a_ready(cur);
    if constexpr (SP2) {
        PG8_STAGE(PG8_SB(0, 0), cB, voffB); PG8_STAGE(PG8_SB(0, 1), cB + hstep, voffB); PG8_STAGE(PG8_SA(0, 0), cA, voffA); PG8_STAGE(PG8_SA(0, 1), cA + hstep, voffA);
        if (wr == 1) PG8_BAR;
        PG8_WAIT_V(2); PG8_BAR;
        PG8_STAGE(PG8_SB(1, 0), cB + kstep, voffB); PG8_STAGE(PG8_SA(1, 0), cA + kstep, voffA); PG8_STAGE(PG8_SB(1, 1), cB + hstep + kstep, voffB);
        PG8_WAIT_V(6); PG8_BAR;
    } else {
        PG8_STAGE(PG8_SB(0, 0), cB, voffB); PG8_STAGE(PG8_SA(0, 0), cA, voffA); PG8_STAGE(PG8_SB(0, 1), cB + hstep, voffB); PG8_STAGE(PG8_SA(0, 1), cA + hstep, voffA);
        if (wr == 1) PG8_BAR;
        PG8_WAIT_V(4); PG8_BAR;
        PG8_STAGE(PG8_SB(1, 0), cB + kstep, voffB); PG8_STAGE(PG8_SA(1, 0), cA + kstep, voffA); PG8_STAGE(PG8_SB(1, 1), cB + hstep + kstep, voffB);
        PG8_WAIT_V(6); PG8_BAR;
    }
    for (;;) {
        const bool has_next = S.next(ui + 1, nxt);
        const char* nA = has_next ? (const char*)g.A + S.a_off(nxt, tstep) : cA; const char* nB = has_next ? (const char*)g.Bt + (size_t)nxt.pn * tstep : cB;
        for (int t = 0; t < nt; t += 2) {
            const bool last = (t == nt - 2);
            const char* a1 = cA + (size_t)(t + 1) * kstep;
            const char* a2 = last ? nA : cA + (size_t)(t + 2) * kstep; const char* b2 = last ? nB : cB + (size_t)(t + 2) * kstep;
            const char* a3 = a2 + kstep; const char* b3 = b2 + kstep;
            if (last && has_next) S.a_ready(nxt);
            if constexpr (SP2) {
            PG8_LDB(B0, 0, 0); PG8_LDB(B1, 0, 1); PG8_SCHED; PG8_LDA(At, 0, 0); PG8_STAGE(PG8_SA(1, 1), a1 + hstep, voffA);
            PG8_WAIT_V(8); PG8_WAIT_L(0); PG8_BAR; PG8_MMA(0, 0, At, B0); PG8_MMA(0, 1, At, B1); PG8_BAR; PG8_SCHED;
            PG8_LDA(At, 0, 1); PG8_STAGE(PG8_SB(0, 0), b2, voffB); PG8_STAGE(PG8_SB(0, 1), b2 + hstep, voffB); PG8_STAGE(PG8_SA(0, 0), a2, voffA);
            PG8_WAIT_V(8); PG8_WAIT_L(0); PG8_BAR; PG8_MMA(1, 0, At, B0); PG8_MMA(1, 1, At, B1); PG8_BAR; PG8_SCHED;
            PG8_LDB(B0, 1, 0); PG8_LDB(B1, 1, 1); PG8_SCHED; PG8_LDA(At, 1, 0); PG8_STAGE(PG8_SA(0, 1), a2 + hstep, voffA);
            PG8_WAIT_V(8); PG8_WAIT_L(0); PG8_BAR; PG8_MMA(0, 0, At, B0); PG8_MMA(0, 1, At, B1); PG8_BAR; PG8_SCHED;
            PG8_LDA(At, 1, 1); PG8_STAGE(PG8_SB(1, 0), b3, voffB); PG8_STAGE(PG8_SB(1, 1), b3 + hstep, voffB); PG8_STAGE(PG8_SA(1, 0), a3, voffA);
            PG8_WAIT_V(8); PG8_WAIT_L(0); PG8_BAR; PG8_MMA(1, 0, At, B0); PG8_MMA(1, 1, At, B1); PG8_BAR; PG8_SCHED;
            } else {
            PG8_LDB(B0, 0, 0); PG8_SCHED; PG8_LDA(At, 0, 0); PG8_STAGE(PG8_SA(1, 1), a1 + hstep, voffA);
            PG8_WAIT_L(8); PG8_BAR; PG8_WAIT_L(0); PG8_MMA(0, 0, At, B0); PG8_BAR; PG8_SCHED;
            PG8_LDB(B1, 0, 1); PG8_STAGE(PG8_SB(0, 0), b2, voffB);
            PG8_BAR; PG8_WAIT_L(0); PG8_MMA(0, 1, At, B1); PG8_BAR;
            PG8_LDA(At, 0, 1); PG8_STAGE(PG8_SA(0, 0), a2, voffA);
            PG8_BAR; PG8_WAIT_L(0); PG8_MMA(1, 0, At, B0); PG8_BAR; PG8_SCHED;
            PG8_STAGE(PG8_SB(0, 1), b2 + hstep, voffB);
            PG8_WAIT_V(6); PG8_BAR; PG8_MMA(1, 1, At, B1); PG8_BAR;
            PG8_LDB(B0, 1, 0); PG8_SCHED; PG8_LDA(At, 1, 0); PG8_STAGE(PG8_SA(0, 1), a2 + hstep, voffA);
            PG8_WAIT_L(8); PG8_BAR; PG8_WAIT_L(0); PG8_MMA(0, 0, At, B0); PG8_BAR; PG8_SCHED;
            PG8_LDB(B1, 1, 1); PG8_STAGE(PG8_SB(1, 0), b3, voffB);
            PG8_BAR; PG8_WAIT_L(0); PG8_MMA(0, 1, At, B1); PG8_BAR;
            PG8_LDA(At, 1, 1); PG8_STAGE(PG8_SA(1, 0), a3, voffA);
            PG8_BAR; PG8_WAIT_L(0); PG8_MMA(1, 0, At, B0); PG8_BAR; PG8_SCHED;
            PG8_STAGE(PG8_SB(1, 1), b3 + hstep, voffB);
            PG8_WAIT_V(6); PG8_BAR; PG8_MMA(1, 1, At, B1); PG8_BAR;
            }
        }
        if constexpr (ALIGN_EPI) { if (wr == 0) PG8_BAR; }
        if constexpr (!Epi::AFTER_DRAIN) { E(acc, cur, wr, wc, fr, fq); S.done(cur); }
        if (!has_next) break;
#pragma unroll
        for (int a = 0; a < 2; ++a)
#pragma unroll
            for (int b = 0; b < 2; ++b)
#pragma unroll
                for (int m = 0; m < 4; ++m)
#pragma unroll
                    for (int n = 0; n < 2; ++n) acc[a][b][m][n] = (f32x4){0.f, 0.f, 0.f, 0.f};
        cur = nxt; cA = nA; cB = nB; ++ui;
        if constexpr (ALIGN_EPI) { if (wr == 1) PG8_BAR; }
    }
    PG8_WAIT_V(0);
    if constexpr (!ALIGN_EPI) { if (wr == 0) PG8_BAR; }
    PG8_BAR;
    if constexpr (Epi::AFTER_DRAIN) { E.fused(acc, cur, wr, wc, fr, fq, lds, wid, lane); S.done(cur); }
#undef PG8_SA
#undef PG8_SB
#undef PG8_STAGE
#undef PG8_LDA
#undef PG8_LDB
#undef PG8_MMA
#undef PG8_WAIT_V
#undef PG8_WAIT_L
#undef PG8_BAR
#undef PG8_SCHED
}
}

constexpr int NWAVES = 8;
constexpr int D = 1024, BATCH = 2, SEQ = 8192, NMETA = 16, M = BATCH * SEQ, MR = M + NMETA;
constexpr int NH = 8, DH = 128, DFF = 2816, NIN = 9 * D, NUP = 2 * DFF;
constexpr float EPS = 1e-6f;
typedef unsigned short bf16;
typedef float f32x4 __attribute__((ext_vector_type(4)));
typedef unsigned u32x4 __attribute__((ext_vector_type(4)));
typedef short bf16x8 __attribute__((ext_vector_type(8)));
#define GAS __attribute__((address_space(1)))
#define LAS __attribute__((address_space(3)))
typedef GAS unsigned gu32;
#define RLX_AGENT __ATOMIC_RELAXED, __HIP_MEMORY_SCOPE_AGENT
#define LDS_WAIT() asm volatile("s_waitcnt lgkmcnt(0)" ::: "memory")
#define VM_WAIT() asm volatile("s_waitcnt vmcnt(0)" ::: "memory")

constexpr size_t MiB = 1u << 20;
constexpr size_t WS_CTL = 0, CTL_ZERO_BYTES = 1 * MiB;
constexpr int CW_BAR = 4096;
constexpr size_t WS_RSS2 = 128 * 1024;
constexpr size_t WS_RSS3 = 256 * 1024;
constexpr size_t WS_LB = 1 * MiB;
constexpr size_t WS_LOGFM = WS_LB + 64 * 1024;
constexpr size_t WS_H1M = WS_LB + 128 * 1024;
constexpr size_t WS_RSTD2 = WS_LB + 192 * 1024;
constexpr size_t WS_WIN = 2 * MiB, WS_WOUT = 20 * MiB, WS_WUP = 22 * MiB, WS_WDN = 33 * MiB;
constexpr size_t WS_XB = 40 * MiB;
constexpr size_t WS_QS = 73 * MiB, WS_V = 106 * MiB, WS_GA = 139 * MiB, WS_BG = 172 * MiB, WS_CX = 205 * MiB;
constexpr size_t WS_O = WS_XB;
constexpr size_t WS_MERGED = WS_QS;
constexpr size_t WS_G = WS_V;
constexpr size_t WS_END = 256 * MiB;
static_assert(WS_V == WS_QS + 33 * MiB && WS_GA == WS_QS + 66 * MiB && WS_BG == WS_QS + 99 * MiB && WS_CX == WS_QS + 132 * MiB, "gate buffers are 33 MiB apart");

constexpr int RING_BYTES = 131072, LDSCTL_OFF = RING_BYTES, MISC_OFF = LDSCTL_OFF + 320, LDS_BYTES = 147456;

__device__ __forceinline__ unsigned f2bf(float f) { unsigned u = __builtin_bit_cast(unsigned, f); return (u + 0x7fffu + ((u >> 16) & 1u)) >> 16; }
__device__ __forceinline__ unsigned pk2(float lo, float hi) { return f2bf(lo) | (f2bf(hi) << 16); }
__device__ __forceinline__ float bf2f(bf16 h) { return __builtin_bit_cast(float, (unsigned)h << 16); }
__device__ __forceinline__ float sigm(float x) { return __builtin_amdgcn_rcpf(1.f + __expf(-x)); }
__device__ __forceinline__ float wave_sum(float v) {
#pragma unroll
    for (int o = 1; o < 64; o <<= 1) v += __shfl_xor(v, o);
    return v;
}

struct P {
    const float *x, *meta, *lbp, *anw, *w_in, *hnw, *cw, *w_out, *fnw, *w_up, *fcw, *fcb, *w_down, *finw;
    float* out; unsigned char* ws;
};

__device__ __forceinline__ float epi1_math(int type, float a, float b, float lb) {
    switch (type) {
        case 0: return a * sigm(a);
        case 1: return __logf(lb + (1.f - lb) * sigm(a));
        case 2: return a;
        case 3: return sigm(b) * a * sigm(a);
        case 4: return sigm(b) * a;
        default: return a * b;
    }
}
struct Epi1 {
    static constexpr bool PERM = true, AFTER_DRAIN = false;
    unsigned char* ws; float* logf; const float* lb;
    __device__ __forceinline__ void operator()(const pg8::f32x4 (&acc)[2][2][4][2], const pg8::Unit& u, int wr, int wc, int fr, int fq) const {
        const int pn = u.pn, type = pn < 12 ? (pn >> 2) : 3 + ((pn - 12) >> 3);
        const int row0 = u.pm * 256 + wr * 64 + fr;
        if (type <= 2) {
            const int cb = (pn & 3) * 256 + wc * 32 + 8 * fq;
            if (type == 1) {
                float lbv[2][8];
#pragma unroll
                for (int bj = 0; bj < 2; ++bj)
#pragma unroll
                    for (int e = 0; e < 8; ++e) lbv[bj][e] = lb[cb + bj * 128 + e];
#pragma unroll
                for (int ai = 0; ai < 2; ++ai)
#pragma unroll
                    for (int m = 0; m < 4; ++m) { float* rowp = logf + (size_t)(row0 + ai * 128 + m * 16) * D + cb;
#pragma unroll
                        for (int bj = 0; bj < 2; ++bj) { pg8::f32x4 o0, o1;
#pragma unroll
                            for (int e = 0; e < 4; ++e) { o0[e] = epi1_math(1, acc[ai][bj][m][0][e], 0.f, lbv[bj][e]); o1[e] = epi1_math(1, acc[ai][bj][m][1][e], 0.f, lbv[bj][4 + e]); }
                            *(pg8::f32x4*)(rowp + bj * 128) = o0; *(pg8::f32x4*)(rowp + bj * 128 + 4) = o1; } }
            } else {
                bf16* base = (bf16*)(ws + WS_QS + (size_t)(type == 0 ? 0 : 1) * (33 * MiB));
#pragma unroll
                for (int ai = 0; ai < 2; ++ai)
#pragma unroll
                    for (int m = 0; m < 4; ++m) { bf16* rowp = base + (size_t)(row0 + ai * 128 + m * 16) * D + cb;
#pragma unroll
                        for (int bj = 0; bj < 2; ++bj) { pg8::f32x4 v0 = acc[ai][bj][m][0], v1 = acc[ai][bj][m][1];
                            if (type == 0) {
#pragma unroll
                                for (int e = 0; e < 4; ++e) { v0[e] = epi1_math(0, v0[e], 0.f, 0.f); v1[e] = epi1_math(0, v1[e], 0.f, 0.f); } }
                            pg8::u32x4 w; w.x = pg8::cvt_pk_bf16(v0[0], v0[1]); w.y = pg8::cvt_pk_bf16(v0[2], v0[3]); w.z = pg8::cvt_pk_bf16(v1[0], v1[1]); w.w = pg8::cvt_pk_bf16(v1[2], v1[3]);
                            *(pg8::u32x4*)(rowp + bj * 128) = w; } }
            }
        } else {
            const int cb = ((pn - 12) & 7) * 128 + wc * 32 + 8 * fq;
            bf16* base = (bf16*)(ws + WS_QS + (size_t)(type - 1) * (33 * MiB));
#pragma unroll
            for (int ai = 0; ai < 2; ++ai)
#pragma unroll
                for (int m = 0; m < 4; ++m) { bf16* rowp = base + (size_t)(row0 + ai * 128 + m * 16) * D + cb;
                    const pg8::f32x4 a0 = acc[ai][0][m][0], a1 = acc[ai][0][m][1], b0 = acc[ai][1][m][0], b1 = acc[ai][1][m][1]; pg8::f32x4 v0, v1;
                    if (type == 3) {
#pragma unroll
                        for (int e = 0; e < 4; ++e) { v0[e] = epi1_math(3, a0[e], b0[e], 0.f); v1[e] = epi1_math(3, a1[e], b1[e], 0.f); }
                    } else if (type == 4) {
#pragma unroll
                        for (int e = 0; e < 4; ++e) { v0[e] = epi1_math(4, a0[e], b0[e], 0.f); v1[e] = epi1_math(4, a1[e], b1[e], 0.f); }
                    } else { v0 = a0 * b0; v1 = a1 * b1; }
                    pg8::u32x4 w; w.x = pg8::cvt_pk_bf16(v0[0], v0[1]); w.y = pg8::cvt_pk_bf16(v0[2], v0[3]); w.z = pg8::cvt_pk_bf16(v1[0], v1[1]); w.w = pg8::cvt_pk_bf16(v1[2], v1[3]);
                    *(pg8::u32x4*)rowp = w; }
        }
    }
};

__host__ __device__ __forceinline__ int win_dst_row(int n) {
    const int g = n >> 10, c = n & 1023, pr = (c >> 7) * 256 + (c & 127);
    switch (g) { case 0: case 1: case 2: return n; case 3: return 3072 + pr; case 7: return 3072 + 128 + pr; case 4: return 5120 + pr; case 8: return 5120 + 128 + pr; case 5: return 7168 + pr; default: return 7168 + 128 + pr; }
}
__host__ __device__ __forceinline__ int wup_dst_row(int n) { const int c = n < DFF ? n : n - DFF; return (c >> 7) * 256 + (c & 127) + (n < DFF ? 0 : 128); }

__device__ __forceinline__ void p0_transpose_item(const float* W, int K, int N, bf16* WT, int dst_row0, const float* kscale, LAS float* scr, int k0, int n0, int lane) {
#pragma unroll 8
    for (int i = 0; i < 32; ++i) { const int kk = 2 * i + (lane >> 5); float w = W[(size_t)(k0 + kk) * N + n0 + (lane & 31)]; if (kscale) w *= kscale[k0 + kk]; scr[kk * 33 + (lane & 31)] = w; }
    LDS_WAIT(); asm volatile("" ::: "memory");
    const int c = lane & 7;
#pragma unroll
    for (int j = 0; j < 4; ++j) { const int n = (lane >> 3) + 8 * j; const LAS float* s = scr + (8 * c) * 33 + n;
        u32x4 o; o.x = pk2(s[0 * 33], s[1 * 33]); o.y = pk2(s[2 * 33], s[3 * 33]); o.z = pk2(s[4 * 33], s[5 * 33]); o.w = pk2(s[6 * 33], s[7 * 33]);
        *(GAS u32x4*)(WT + (size_t)(dst_row0 + n) * K + k0 + 8 * c) = o; }
    LDS_WAIT(); asm volatile("" ::: "memory");
}
__device__ __forceinline__ const float* h0row(const P& p, int r) { return r < M ? p.x + (size_t)r * D : p.meta + (size_t)(r - M) * D; }
__device__ __forceinline__ void p0_prologue(const P& p, LAS unsigned char* lds, int vcu, int G, int wave, int lane) {
    LAS float* scr = (LAS float*)(lds + wave * 16384);
    const int gw = vcu * NWAVES + wave, NGW = G * NWAVES;
    constexpr int I_IN = (D / 64) * (NIN / 32), I_OUT = (D / 64) * (D / 32), I_UP = (D / 64) * (NUP / 32), I_DN = (DFF / 64) * (D / 32);
    constexpr int NITEMS = I_IN + I_OUT + I_UP + I_DN;
    bf16* win = (bf16*)(p.ws + WS_WIN); bf16* wout = (bf16*)(p.ws + WS_WOUT); bf16* wup = (bf16*)(p.ws + WS_WUP); bf16* wdn = (bf16*)(p.ws + WS_WDN);
    for (int it = gw; it < NITEMS; it += NGW) {
        int r = it;
        if (r < I_IN) { const int nblk = NIN / 32, kb = r / nblk, nb = r % nblk; p0_transpose_item(p.w_in, D, NIN, win, win_dst_row(32 * nb), p.anw, scr, 64 * kb, 32 * nb, lane); continue; } r -= I_IN;
        if (r < I_OUT) { const int nblk = D / 32, kb = r / nblk, nb = r % nblk; p0_transpose_item(p.w_out, D, D, wout, 32 * nb, nullptr, scr, 64 * kb, 32 * nb, lane); continue; } r -= I_OUT;
        if (r < I_UP) { const int nblk = NUP / 32, kb = r / nblk, nb = r % nblk; p0_transpose_item(p.w_up, D, NUP, wup, wup_dst_row(32 * nb), p.fnw, scr, 64 * kb, 32 * nb, lane); continue; } r -= I_UP;
        { const int nblk = D / 32, kb = r / nblk, nb = r % nblk; p0_transpose_item(p.w_down, DFF, D, wdn, 32 * nb, nullptr, scr, 64 * kb, 32 * nb, lane); }
    }
    bf16* xb = (bf16*)(p.ws + WS_XB);
    for (int m = gw; m < MR; m += NGW) {
        const GAS f32x4* xr = (const GAS f32x4*)h0row(p, m) + lane;
        f32x4 v[4]; float s = 0.f;
#pragma unroll
        for (int j = 0; j < 4; ++j) { v[j] = xr[64 * j]; s += (v[j].x * v[j].x + v[j].y * v[j].y) + (v[j].z * v[j].z + v[j].w * v[j].w); }
        const float rstd = 1.f / sqrtf(wave_sum(s) * (1.f / D) + EPS);
        GAS unsigned long long* o8 = (GAS unsigned long long*)(xb + (size_t)m * D) + lane;
#pragma unroll
        for (int j = 0; j < 4; ++j) o8[64 * j] = (unsigned long long)pk2(v[j].x * rstd, v[j].y * rstd) | ((unsigned long long)pk2(v[j].z * rstd, v[j].w * rstd) << 32);
    }
    if (gw < 16) { float* lb = (float*)(p.ws + WS_LB); const int c = gw * 64 + lane; lb[c] = 1.f / (1.f + __expf(p.lbp[D + c] - p.lbp[c])); }
}

__device__ __forceinline__ void aux_meta_gemm1(const P& p, int gw, int NGW, int lane) {
    const bf16* xb = (const bf16*)(p.ws + WS_XB); const bf16* win = (const bf16*)(p.ws + WS_WIN); const float* lbp = (const float*)(p.ws + WS_LB);
    const int fr = lane & 15, fq = lane >> 4;
    for (int task = gw; task < 384; task += NGW) {
        const int type = task >> 6, cb = (task & 63) * 16;
        int rowA, rowB = 0;
        if (type <= 2) rowA = type * 1024 + cb; else { rowA = 3072 + (type - 3) * 2048 + (cb >> 7) * 256 + (cb & 127); rowB = rowA + 128; }
        const bf16* ap = xb + (size_t)(M + fr) * D + 8 * fq;
        const bf16* b0p = win + (size_t)(rowA + fr) * D + 8 * fq;
        const bf16* b1p = win + (size_t)(rowB + fr) * D + 8 * fq;
        pg8::f32x4 acc0 = {0.f, 0.f, 0.f, 0.f}, acc1 = {0.f, 0.f, 0.f, 0.f};
#pragma unroll 4
        for (int kk = 0; kk < D / 32; ++kk) {
            const bf16x8 a = *(const bf16x8*)(ap + kk * 32), b0 = *(const bf16x8*)(b0p + kk * 32);
            acc0 = __builtin_amdgcn_mfma_f32_16x16x32_bf16(a, b0, acc0, 0, 0, 0);
            if (type >= 3) { const bf16x8 b1 = *(const bf16x8*)(b1p + kk * 32); acc1 = __builtin_amdgcn_mfma_f32_16x16x32_bf16(a, b1, acc1, 0, 0, 0); }
        }
        const int ch = cb + fr; const float lb = lbp[ch];
        bf16* dst = (bf16*)(p.ws + WS_QS + (size_t)(type == 0 ? 0 : type - 1) * (33 * MiB));
#pragma unroll
        for (int e = 0; e < 4; ++e) { const int mrow = 4 * fq + e; const float o = epi1_math(type, acc0[e], acc1[e], lb);
            if (type == 1) ((float*)(p.ws + WS_LOGFM))[(size_t)mrow * D + ch] = o; else dst[(size_t)(M + mrow) * D + ch] = (bf16)f2bf(o); }
    }
}

__device__ __forceinline__ const float* logfrow(const P& p, int r) { return r < M ? p.out + (size_t)r * D : (const float*)(p.ws + WS_LOGFM) + (size_t)(r - M) * D; }
__device__ __forceinline__ int prevrow(int r, int j) {
    if (r < M) { const int t = r % SEQ; return t >= j ? r - j : M + NMETA + (t - j); }
    const int m = r - M; return m >= j ? r - j : -1;
}
__device__ __forceinline__ void naive_hgrn(const P& p, int gw, int lane) {
    if (gw >= BATCH * NH * DH) return;
    const int b = gw / (NH * DH), h = (gw / DH) % NH, vc = gw % DH;
    const bf16* qs = (const bf16*)(p.ws + WS_QS); const bf16* vb = (const bf16*)(p.ws + WS_V); bf16* ob = (bf16*)(p.ws + WS_O);
    float S0 = 0.f, S1 = 0.f;
    for (int t0 = 0; t0 < NMETA + SEQ; t0 += 4) {
        float lf0[4], lf1[4], q0[4], q1[4], vv[4]; int rr[4];
#pragma unroll
        for (int u = 0; u < 4; ++u) {
            const int t = t0 + u; const int r = t < NMETA ? M + t : b * SEQ + (t - NMETA); rr[u] = r;
            const size_t o = (size_t)r * D + h * DH; const float* lf = logfrow(p, r) + h * DH;
            lf0[u] = lf[lane]; lf1[u] = lf[64 + lane]; q0[u] = bf2f(qs[o + lane]); q1[u] = bf2f(qs[o + 64 + lane]); vv[u] = bf2f(vb[o + vc]);
        }
#pragma unroll
        for (int u = 0; u < 4; ++u) {
            const float f0 = __expf(lf0[u]), f1 = __expf(lf1[u]);
            S0 = f0 * S0 + (1.f - f0) * vv[u]; S1 = f1 * S1 + (1.f - f1) * vv[u];
            const float o = wave_sum(q0[u] * S0 + q1[u] * S1);
            if (lane == 0 && (rr[u] < M || b == 0)) ob[(size_t)rr[u] * D + h * DH + vc] = (bf16)f2bf(o);
        }
    }
}
__device__ __forceinline__ void naive_merge(const P& p, int gw, int NGW, int lane) {
    const bf16* ob = (const bf16*)(p.ws + WS_O); const bf16* ga = (const bf16*)(p.ws + WS_GA); const bf16* bg = (const bf16*)(p.ws + WS_BG); const bf16* cx = (const bf16*)(p.ws + WS_CX);
    bf16* merged = (bf16*)(p.ws + WS_MERGED);
    for (int it = gw; it < MR * NH; it += NGW) {
        const int r = it / NH, h = it % NH, c0 = h * DH + lane, c1 = c0 + 64;
        const float o0 = bf2f(ob[(size_t)r * D + c0]), o1 = bf2f(ob[(size_t)r * D + c1]);
        const float rs = 1.f / sqrtf(wave_sum(o0 * o0 + o1 * o1) * (1.f / DH) + EPS);
        const int r1 = prevrow(r, 1), r2 = prevrow(r, 2);
#pragma unroll
        for (int e = 0; e < 2; ++e) {
            const int c = e ? c1 : c0; const float o = e ? o1 : o0;
            const float ya = o * rs * p.hnw[c & (DH - 1)] * bf2f(ga[(size_t)r * D + c]);
            const float x0 = bf2f(cx[(size_t)r * D + c]), x1 = r1 >= 0 ? bf2f(cx[(size_t)r1 * D + c]) : 0.f, x2 = r2 >= 0 ? bf2f(cx[(size_t)r2 * D + c]) : 0.f;
            const float conv = p.cw[c] * x2 + p.cw[D + c] * x1 + p.cw[2 * D + c] * x0;
            merged[(size_t)r * D + c] = (bf16)f2bf(ya + bf2f(bg[(size_t)r * D + c]) * conv);
        }
    }
}
__device__ __forceinline__ const float* h1row(const P& p, int r) { return r < M ? p.out + (size_t)r * D : (const float*)(p.ws + WS_H1M) + (size_t)(r - M) * D; }
__device__ __forceinline__ void naive_gemm2(const P& p, int vbx, int vby, int t256) {
    const int c = vbx * 256 + t256, r0 = vby * 4;
    const bf16* merged = (const bf16*)(p.ws + WS_MERGED);
    float acc[4] = {0.f, 0.f, 0.f, 0.f};
    for (int k = 0; k < D; ++k) { const float w = p.w_out[(size_t)k * D + c];
#pragma unroll
        for (int i = 0; i < 4; ++i) acc[i] += bf2f(merged[(size_t)(r0 + i) * D + k]) * w; }
#pragma unroll
    for (int i = 0; i < 4; ++i) { const int r = r0 + i; const float v = h0row(p, r)[c] + acc[i];
        if (r < M) p.out[(size_t)r * D + c] = v; else ((float*)(p.ws + WS_H1M))[(size_t)(r - M) * D + c] = v; }
}
__device__ __forceinline__ void naive_rstd2(const P& p, int gw, int NGW, int lane) {
    for (int r = gw; r < MR; r += NGW) { const float* xr = h1row(p, r); float s = 0.f;
        for (int k = lane; k < D; k += 64) { const float v = xr[k]; s += v * v; }
        s = wave_sum(s);
        if (lane == 0) ((float*)(p.ws + WS_RSTD2))[r] = 1.f / sqrtf(s * (1.f / D) + EPS); }
}
__device__ __forceinline__ void naive_gemm3(const P& p, int vbx, int vby, int t256) {
    const int c = vbx * 256 + t256, r0 = vby * 4;
    const float* rstd = (const float*)(p.ws + WS_RSTD2);
    int rows[6]; rows[0] = prevrow(r0, 2); rows[1] = prevrow(r0, 1);
#pragma unroll
    for (int i = 0; i < 4; ++i) rows[2 + i] = r0 + i;
    const float* hr[6];
#pragma unroll
    for (int i = 0; i < 6; ++i) hr[i] = h1row(p, rows[i]);
    float aa[6], vv[4];
#pragma unroll
    for (int i = 0; i < 6; ++i) aa[i] = 0.f;
#pragma unroll
    for (int i = 0; i < 4; ++i) vv[i] = 0.f;
    for (int k = 0; k < D; ++k) {
        const float nw = p.fnw[k]; const float wa = p.w_up[(size_t)k * NUP + c] * nw, wv = p.w_up[(size_t)k * NUP + DFF + c] * nw;
#pragma unroll
        for (int i = 0; i < 6; ++i) { const float hv = hr[i][k]; aa[i] += hv * wa; if (i >= 2) vv[i - 2] += hv * wv; }
    }
#pragma unroll
    for (int i = 0; i < 6; ++i) aa[i] *= rstd[rows[i]];
    const float w0 = p.fcw[c], w1 = p.fcw[DFF + c], w2 = p.fcw[2 * DFF + c], bb = p.fcb[c];
    bf16* g = (bf16*)(p.ws + WS_G);
#pragma unroll
    for (int i = 0; i < 4; ++i) { const float a = w0 * aa[i] + w1 * aa[i + 1] + w2 * aa[i + 2] + bb; const float val = vv[i] * rstd[r0 + i];
        g[(size_t)(r0 + i) * DFF + c] = (bf16)f2bf(a * sigm(a) * val); }
}
__device__ __forceinline__ void naive_gemm4(const P& p, int vbx, int vby, int t256) {
    const int c = vbx * 256 + t256, r0 = vby * 4;
    const bf16* g = (const bf16*)(p.ws + WS_G);
    float acc[4] = {0.f, 0.f, 0.f, 0.f};
    for (int k = 0; k < DFF; ++k) { const float w = p.w_down[(size_t)k * D + c];
#pragma unroll
        for (int i = 0; i < 4; ++i) acc[i] += bf2f(g[(size_t)(r0 + i) * DFF + k]) * w; }
#pragma unroll
    for (int i = 0; i < 4; ++i) p.out[(size_t)(r0 + i) * D + c] += acc[i];
}
__device__ __forceinline__ void naive_final(const P& p, int gw, int NGW, int lane) {
    for (int r = gw; r < M; r += NGW) {
        float* xr = p.out + (size_t)r * D; float v[16]; float s = 0.f;
#pragma unroll
        for (int j = 0; j < 16; ++j) { v[j] = xr[lane + 64 * j]; s += v[j] * v[j]; }
        s = wave_sum(s); const float rs = 1.f / sqrtf(s * (1.f / D) + EPS);
#pragma unroll
        for (int j = 0; j < 16; ++j) xr[lane + 64 * j] = v[j] * rs * p.finw[lane + 64 * j];
    }
}

constexpr int H1B_ROWS = 8384;
constexpr size_t WS_H1B = WS_XB;
struct Epi2 {
    static constexpr bool PERM = false, AFTER_DRAIN = false;
    const float* x; float* out; bf16* h1b; float* rss;
    __device__ __forceinline__ void operator()(const pg8::f32x4 (&acc)[2][2][4][2], const pg8::Unit& u, int wr, int wc, int fr, int fq) const {
        const int col0 = u.pn * 256 + wc * 32 + 4 * fq;
#pragma unroll
        for (int ai = 0; ai < 2; ++ai)
#pragma unroll
            for (int m = 0; m < 4; ++m) {
                const int r = u.pm * 256 + ai * 128 + wr * 64 + m * 16 + fr; const size_t off = (size_t)r * D + col0;
                bf16* hb = h1b + ((size_t)((r >> 13) * H1B_ROWS + 2 + (r & (SEQ - 1)))) * D + col0; float ss = 0.f;
#pragma unroll
                for (int bj = 0; bj < 2; ++bj)
#pragma unroll
                    for (int n = 0; n < 2; ++n) { const pg8::f32x4 h = *(const pg8::f32x4*)(x + off + bj * 128 + n * 16) + acc[ai][bj][m][n];
                        *(pg8::f32x4*)(out + off + bj * 128 + n * 16) = h; ss += (h[0] * h[0] + h[1] * h[1]) + (h[2] * h[2] + h[3] * h[3]);
                        uint2 w; w.x = pg8::cvt_pk_bf16(h[0], h[1]); w.y = pg8::cvt_pk_bf16(h[2], h[3]); *(uint2*)(hb + bj * 128 + n * 16) = w; }
                ss += __shfl_xor(ss, 16); ss += __shfl_xor(ss, 32);
                if (fq == 0) atomicAdd(rss + r, ss);
            }
    }
};
__device__ __forceinline__ void aux_meta_gemm2(const P& p, const bf16* merged  , int gw, int NGW, int lane) {
    const bf16* wout = (const bf16*)(p.ws + WS_WOUT); bf16* h1b = (bf16*)(p.ws + WS_H1B); float* rss = (float*)(p.ws + WS_RSS2); float* h1m = (float*)(p.ws + WS_H1M);
    const int fr = lane & 15, fq = lane >> 4;
    for (int task = gw; task < D / 16; task += NGW) {
        const int cb = task * 16;
        const bf16* ap = merged + (size_t)fr * D + 8 * fq; const bf16* bp = wout + (size_t)(cb + fr) * D + 8 * fq;
        pg8::f32x4 acc = {0.f, 0.f, 0.f, 0.f};
#pragma unroll 4
        for (int kk = 0; kk < D / 32; ++kk) acc = __builtin_amdgcn_mfma_f32_16x16x32_bf16(*(const bf16x8*)(ap + kk * 32), *(const bf16x8*)(bp + kk * 32), acc, 0, 0, 0);
        const int ch = cb + fr;
#pragma unroll
        for (int e = 0; e < 4; ++e) { const int mrow = 4 * fq + e; const float h = p.meta[(size_t)mrow * D + ch] + acc[e];
            h1m[(size_t)mrow * D + ch] = h;
            if (mrow >= 14) { const bf16 hb = (bf16)f2bf(h); h1b[(size_t)(mrow - 14) * D + ch] = hb; h1b[((size_t)H1B_ROWS + (mrow - 14)) * D + ch] = hb; }
            float ss = h * h; ss += __shfl_xor(ss, 1); ss += __shfl_xor(ss, 2); ss += __shfl_xor(ss, 4); ss += __shfl_xor(ss, 8);
            if (fr == 0) atomicAdd(rss + M + mrow, ss); }
    }
}

constexpr int G3_TILES_PER_BATCH = 33, G3_STEP = 254, XCH_OFF = LDSCTL_OFF + 1024;
struct Sched3 : pg8::StaticOrder {
    __device__ __forceinline__ size_t a_off(const pg8::Unit& u, size_t  ) const { const int b = u.pm / G3_TILES_PER_BATCH, pmb = u.pm % G3_TILES_PER_BATCH; return (size_t)(b * H1B_ROWS + G3_STEP * pmb) * D * 2; }
};
__device__ __forceinline__ float dpp_ror1(float v) { return __builtin_bit_cast(float, __builtin_amdgcn_mov_dpp(__builtin_bit_cast(int, v), 0x121, 0xf, 0xf, false)); }
__device__ __forceinline__ float dpp_ror2(float v) { return __builtin_bit_cast(float, __builtin_amdgcn_mov_dpp(__builtin_bit_cast(int, v), 0x122, 0xf, 0xf, false)); }
struct Epi3 {
    static constexpr bool PERM = true, AFTER_DRAIN = false;
    bf16* g; const float* rss; const float* fcw; const float* fcb; LAS float* xch;
    __device__ __forceinline__ void operator()(const pg8::f32x4 (&acc)[2][2][4][2], const pg8::Unit& u, int wr, int wc, int fr, int fq) const {
        const int b = u.pm / G3_TILES_PER_BATCH, pmb = u.pm % G3_TILES_PER_BATCH, t0 = G3_STEP * pmb - 2;
        const int chl = wc * 32 + 8 * fq, ch = u.pn * 128 + chl;
        float w0[8], w1[8], w2[8], bb[8];
#pragma unroll
        for (int e = 0; e < 8; ++e) { w0[e] = fcw[ch + e]; w1[e] = fcw[DFF + ch + e]; w2[e] = fcw[2 * DFF + ch + e]; bb[e] = fcb[ch + e]; }
        float rs[2][4];
#pragma unroll
        for (int ai = 0; ai < 2; ++ai)
#pragma unroll
            for (int m = 0; m < 4; ++m) { const int t = t0 + ai * 128 + wr * 64 + m * 16 + fr; float s = 0.f;
                if (t < SEQ) { const int ri = t >= 0 ? b * SEQ + t : M + NMETA + t; s = 1.f / sqrtf(rss[ri] * (1.f / D) + EPS); }
                rs[ai][m] = s; }
        if (fr >= 14) {
#pragma unroll
            for (int ai = 0; ai < 2; ++ai) { LAS float* dst = xch + ((2 * ai + wr) * 2 + (fr - 14)) * 128 + chl;
#pragma unroll
                for (int e = 0; e < 8; ++e) dst[e] = acc[ai][0][3][e >> 2][e & 3] * rs[ai][3]; }
        }
        asm volatile("s_waitcnt lgkmcnt(0)" ::: "memory"); __builtin_amdgcn_s_barrier(); asm volatile("" ::: "memory");
#pragma unroll
        for (int ai = 0; ai < 2; ++ai) {
            const int q = 2 * ai + wr; float prev[8];
#pragma unroll
            for (int e = 0; e < 8; ++e) prev[e] = 0.f;
            if (q >= 1 && fr >= 14) { const LAS float* src = xch + ((q - 1) * 2 + (fr - 14)) * 128 + chl;
#pragma unroll
                for (int e = 0; e < 8; ++e) prev[e] = src[e]; }
#pragma unroll
            for (int m = 0; m < 4; ++m) {
                const int i = ai * 128 + wr * 64 + m * 16 + fr, t = t0 + i; float cur[8], o[8];
#pragma unroll
                for (int e = 0; e < 8; ++e) cur[e] = acc[ai][0][m][e >> 2][e & 3] * rs[ai][m];
#pragma unroll
                for (int e = 0; e < 8; ++e) {
                    const float c1 = dpp_ror1(cur[e]), c2 = dpp_ror2(cur[e]), q1 = dpp_ror1(prev[e]), q2 = dpp_ror2(prev[e]);
                    const float p1 = fr >= 1 ? c1 : q1, p2 = fr >= 2 ? c2 : q2;
                    const float a = w0[e] * p2 + w1[e] * p1 + w2[e] * cur[e] + bb[e];
                    o[e] = a * sigm(a) * (acc[ai][1][m][e >> 2][e & 3] * rs[ai][m]);
                }
                if (i >= 2 && t < SEQ) { pg8::u32x4 w; w.x = pg8::cvt_pk_bf16(o[0], o[1]); w.y = pg8::cvt_pk_bf16(o[2], o[3]); w.z = pg8::cvt_pk_bf16(o[4], o[5]); w.w = pg8::cvt_pk_bf16(o[6], o[7]);
                    *(pg8::u32x4*)(g + (size_t)(b * SEQ + t) * DFF + ch) = w; }
#pragma unroll
                for (int e = 0; e < 8; ++e) prev[e] = cur[e];
            }
        }
    }
};

struct Epi4 {
    static constexpr bool PERM = false, AFTER_DRAIN = false;
    float* out; float* rss;
    __device__ __forceinline__ void operator()(const pg8::f32x4 (&acc)[2][2][4][2], const pg8::Unit& u, int wr, int wc, int fr, int fq) const {
        const int col0 = u.pn * 256 + wc * 32 + 4 * fq;
#pragma unroll
        for (int ai = 0; ai < 2; ++ai)
#pragma unroll
            for (int m = 0; m < 4; ++m) {
                const int r = u.pm * 256 + ai * 128 + wr * 64 + m * 16 + fr; const size_t off = (size_t)r * D + col0; float ss = 0.f;
#pragma unroll
                for (int bj = 0; bj < 2; ++bj)
#pragma unroll
                    for (int n = 0; n < 2; ++n) { const pg8::f32x4 h = *(const pg8::f32x4*)(out + off + bj * 128 + n * 16) + acc[ai][bj][m][n];
                        *(pg8::f32x4*)(out + off + bj * 128 + n * 16) = h; ss += (h[0] * h[0] + h[1] * h[1]) + (h[2] * h[2] + h[3] * h[3]); }
                ss += __shfl_xor(ss, 16); ss += __shfl_xor(ss, 32);
                if (fq == 0) atomicAdd(rss + r, ss);
            }
    }
};
__device__ __forceinline__ void final_norm(const P& p, int gw, int NGW, int lane) {
    const float* rss = (const float*)(p.ws + WS_RSS3);
    f32x4 wv[4];
#pragma unroll
    for (int j = 0; j < 4; ++j) wv[j] = ((const f32x4*)p.finw)[lane + 64 * j];
    for (int r = gw; r < M; r += NGW) {
        const float rs = 1.f / sqrtf(__hip_atomic_load(rss + r, __ATOMIC_RELAXED, __HIP_MEMORY_SCOPE_AGENT) * (1.f / D) + EPS); f32x4* xr     = (f32x4*)(p.out + (size_t)r * D) + lane;
#pragma unroll
        for (int j = 0; j < 4; ++j) xr[64 * j] = xr[64 * j] * rs * wv[j];
    }
}

typedef float f32x16 __attribute__((ext_vector_type(16)));
typedef short v4i16_t __attribute__((ext_vector_type(4)));
typedef float f32x2 __attribute__((ext_vector_type(2)));
constexpr size_t WS_ST = WS_XB;
constexpr size_t WS_GAM = WS_LB + 512 * 1024;
constexpr size_t WS_MERGEDM = WS_LB + 832 * 1024;
constexpr size_t WS_DUMP = WS_LB + 800 * 1024;
constexpr int HG_GROUP_BYTES = 57344, HG_QG = 0, HG_KG = 16384, HG_V = 32768, HG_OL = 0, HG_T = 49152, HG_VEC = 51200, HG_SS = 52736, OL_PITCH = 528;
static_assert(64 * OL_PITCH <= HG_T && HG_SS + 1024 <= HG_GROUP_BYTES && 2 * HG_GROUP_BYTES <= RING_BYTES, "hgrn LDS map");
typedef __bf16 bf16x2_t __attribute__((ext_vector_type(2)));
__device__ __forceinline__ unsigned cvtpk(float lo, float hi) { const f32x2 v = {lo, hi}; return __builtin_bit_cast(unsigned, __builtin_convertvector(v, bf16x2_t)); }
__device__ __forceinline__ bf16x8 pack8(float a0, float a1, float a2, float a3, float a4, float a5, float a6, float a7) {
    u32x4 w; w.x = cvtpk(a0, a1); w.y = cvtpk(a2, a3); w.z = cvtpk(a4, a5); w.w = cvtpk(a6, a7); return __builtin_bit_cast(bf16x8, w); }
__device__ __forceinline__ bf16x8 tr_pair(const LAS unsigned char* pa, const LAS unsigned char* pb) {
    const v4i16_t a = __builtin_amdgcn_ds_read_tr16_b64_v4i16((LAS v4i16_t*)pa), b = __builtin_amdgcn_ds_read_tr16_b64_v4i16((LAS v4i16_t*)pb);
    return (bf16x8){a[0], a[1], a[2], a[3], b[0], b[1], b[2], b[3]}; }
__device__ __forceinline__ float bflo(unsigned u) { return __builtin_bit_cast(float, u << 16); }
__device__ __forceinline__ float bfhi(unsigned u) { return __builtin_bit_cast(float, u & 0xffff0000u); }
__device__ __forceinline__ int hg_trb(int ct, int pc, int b8, int hh, int q4, int g16) { return 256 * (4 * hh + q4 + 8 * b8) + 16 * (4 * (ct ^ q4) + 2 * (g16 ^ b8) + ((pc >> 1) ^ hh)) + 8 * (pc & 1); }
#define HG_SB() __builtin_amdgcn_sched_barrier(0)

template <bool FULL>
__device__ __forceinline__ void hgrn_units(const P& p, LAS unsigned char* lds, int bx, int G, int tid) {
    const int grp = tid >> 8, gt = tid & 255, w = __builtin_amdgcn_readfirstlane(gt >> 6), lane = tid & 63;
    LAS unsigned char* L = lds + grp * HG_GROUP_BYTES;
    const bf16* qs = (const bf16*)(p.ws + WS_QS); const bf16* vb = (const bf16*)(p.ws + WS_V);
    float* st = (float*)(p.ws + WS_ST); float* gam = (float*)(p.ws + WS_GAM);
    for (int u0 = bx * 2; u0 < 512; u0 += 2 * G) {
        const int unit = u0 + grp, seg = unit >> 4, bh = unit & 15, b = bh >> 3, h = bh & 7, slot = bh * 32 + seg;
        if (!FULL && seg == 31) continue;
        const int nch = seg == 0 ? 5 : 4;
        f32x16 S[4];
#pragma unroll
        for (int dt = 0; dt < 4; ++dt) {
            if (FULL && seg > 0) {
#pragma unroll
                for (int rg = 0; rg < 16; ++rg) S[dt][rg] = st[(size_t)(slot - 1) * 16384 + ((w * 4 + dt) * 16 + rg) * 64 + lane];
            } else {
#pragma unroll
                for (int rg = 0; rg < 16; ++rg) S[dt][rg] = 0.f;
            }
        }
        float gt0 = 0.f, gt1 = 0.f;
        for (int c = 0; c < nch; ++c) {
            const bool metac = (seg == 0 && c == 0);
            const int rbase = b * SEQ + seg * 256 + (seg == 0 ? c - 1 : c) * 64;
            float lx[16], ly[16]; unsigned qv[16]; u32x4 vx[4];
            int gtA = gt; asm volatile("" : "+v"(gtA));
            const int laneA = gtA & 63, tv = gtA >> 2, swv = ((tv & 3) << 2) | ((tv >> 2) & 3), vwb = 256 * tv, wa = 4096 * w + (laneA << 2);
            {
                const bool valid = !metac || w == 3;
                const float vmf = valid ? 1.f : 0.f; const unsigned vmu = valid ? 0xffffffffu : 0u;
                const int row0 = metac ? M : rbase + 16 * w;
                const float* lfp = (metac ? (const float*)(p.ws + WS_LOGFM) : p.out + (size_t)row0 * D) + h * DH + 2 * laneA;
                const bf16* qp = qs + (size_t)row0 * D + h * DH + 2 * laneA;
#pragma unroll
                for (int i = 0; i < 16; ++i) {
                    const f32x2 lf = *(const f32x2*)(lfp + (size_t)i * D);
                    lx[i] = lf.x * vmf; ly[i] = lf.y * vmf;
                    if (FULL) { const unsigned q2 = *(const unsigned*)(qp + (size_t)i * D); qv[i] = q2 & vmu; }
                }
                const bool vvalid = !metac || tv >= 48; const unsigned vvm = vvalid ? 0xffffffffu : 0u; const int rv = metac ? M + (tv >= 48 ? tv - 48 : 0) : rbase + tv;
                const bf16* vp = vb + (size_t)rv * D + h * DH + 32 * (gtA & 3);
#pragma unroll
                for (int i4 = 0; i4 < 4; ++i4) { const u32x4 x = *(const u32x4*)(vp + 8 * i4); vx[i4] = x & vvm; }
            }
            float gx = 0.f, gy = 0.f;
#pragma unroll
            for (int i = 0; i < 16; ++i) { gx += lx[i]; gy += ly[i]; lx[i] = gx; ly[i] = gy; }
            LAS float* T = (LAS float*)(L + HG_T);
            *(LAS f32x2*)(T + w * 128 + 2 * laneA) = (f32x2){gx, gy};
            __syncthreads();
            {
#pragma unroll
                for (int i4 = 0; i4 < 4; ++i4) *(LAS u32x4*)(L + HG_V + vwb + ((((gtA & 3) * 4 + i4) ^ swv) << 4)) = vx[i4];
                const f32x2 t0 = *(const LAS f32x2*)(T + 0 * 128 + 2 * laneA), t1 = *(const LAS f32x2*)(T + 1 * 128 + 2 * laneA), t2 = *(const LAS f32x2*)(T + 2 * 128 + 2 * laneA), t3 = *(const LAS f32x2*)(T + 3 * 128 + 2 * laneA);
                const float ox = (w > 0 ? t0.x : 0.f) + (w > 1 ? t1.x : 0.f) + (w > 2 ? t2.x : 0.f), oy = (w > 0 ? t0.y : 0.f) + (w > 1 ? t1.y : 0.f) + (w > 2 ? t2.y : 0.f);
                const float Rx = t0.x + t1.x, Ry = t0.y + t1.y, Ex = Rx + t2.x + t3.x, Ey = Ry + t2.y + t3.y;
#pragma unroll
                for (int i = 0; i < 16; ++i) {
                    const float ax = ox + lx[i] - Rx, ay = oy + ly[i] - Ry;
                    const float kx = 1.f - __expf(i ? lx[i] - lx[i - 1] : lx[0]), ky = 1.f - __expf(i ? ly[i] - ly[i - 1] : ly[0]);
                    const int off = 256 * i + (wa ^ ((((i & 3) << 2) | ((i >> 2) & 3)) << 4));
                    *(LAS unsigned*)(L + HG_KG + off) = cvtpk(kx * __expf(-ax), ky * __expf(-ay));
                    if (FULL) *(LAS unsigned*)(L + HG_QG + off) = cvtpk(bflo(qv[i]) * __expf(ax), bfhi(qv[i]) * __expf(ay));
                }
                if (w == 0) {
                    LAS float* V = (LAS float*)(L + HG_VEC);
                    *(LAS f32x2*)(V + 2 * laneA) = (f32x2){__expf(Rx), __expf(Ry)};
                    *(LAS f32x2*)(V + 128 + 2 * laneA) = (f32x2){__expf(Ex), __expf(Ey)};
                    *(LAS f32x2*)(V + 256 + 2 * laneA) = (f32x2){__expf(Ex - Rx), __expf(Ey - Ry)};
                    gt0 += Ex; gt1 += Ey;
                }
            }
            __syncthreads();
            HG_SB();
            int laneB = lane; asm volatile("" : "+v"(laneB));
            const int r = laneB & 31, hh = laneB >> 5, g16 = (laneB >> 4) & 1, i16 = laneB & 15;
            int rx[8];
            { const int swr = ((r & 3) << 2) | ((r >> 2) & 3), rb = 256 * r + 16 * (hh ^ (swr & 1)), xh = (swr & 0xE) << 4;
#pragma unroll
              for (int kk = 0; kk < 8; ++kk) rx[kk] = rb + ((kk << 5) ^ xh); }
            const int q4 = i16 >> 2, pp = i16 & 3, pps = pp == 1 ? 2 : (pp == 2 ? 1 : pp);
            const int tv0 = hg_trb(w, pp, 0, hh, q4, g16), tv1 = hg_trb(w, pp, 1, hh, q4, g16);
            int tk0[4], tk1[4];
#pragma unroll
            for (int dt = 0; dt < 4; ++dt) { tk0[dt] = hg_trb(dt, pps, 0, hh, q4, g16); tk1[dt] = hg_trb(dt, pps, 1, hh, q4, g16); }
            const LAS float* V = (const LAS float*)(L + HG_VEC);
            bf16x8 vf[4];
#pragma unroll
            for (int ks = 0; ks < 4; ++ks) vf[ks] = tr_pair(L + HG_V + 4096 * ks + tv0, L + HG_V + 4096 * ks + tv1);
            f32x16 o[2];
            if (FULL) {
#pragma unroll
                for (int tt = 0; tt < 2; ++tt)
#pragma unroll
                    for (int rg = 0; rg < 16; ++rg) o[tt][rg] = 0.f;
#pragma unroll
                for (int dt = 0; dt < 4; ++dt) {
                    bf16x8 Sp[2];
#pragma unroll
                    for (int ks = 0; ks < 2; ++ks) { const f32x4 ea = *(const LAS f32x4*)(V + 32 * dt + 16 * ks + 8 * hh), eb = *(const LAS f32x4*)(V + 32 * dt + 16 * ks + 8 * hh + 4);
                        Sp[ks] = pack8(S[dt][8 * ks + 0] * ea[0], S[dt][8 * ks + 1] * ea[1], S[dt][8 * ks + 2] * ea[2], S[dt][8 * ks + 3] * ea[3], S[dt][8 * ks + 4] * eb[0], S[dt][8 * ks + 5] * eb[1], S[dt][8 * ks + 6] * eb[2], S[dt][8 * ks + 7] * eb[3]); }
#pragma unroll
                    for (int tt = 0; tt < 2; ++tt)
#pragma unroll
                        for (int ks = 0; ks < 2; ++ks) { const bf16x8 qf = *(const LAS bf16x8*)(L + HG_QG + 8192 * tt + rx[2 * dt + ks]);
                            o[tt] = __builtin_amdgcn_mfma_f32_32x32x16_bf16(Sp[ks], qf, o[tt], 0, 0, 0); }
                    HG_SB();
                }
#pragma unroll
                for (int tile = 0; tile < 3; ++tile) {
                    const int si = tile == 2 ? 1 : 0, tj = tile == 0 ? 0 : 1;
                    f32x16 at;
#pragma unroll
                    for (int rg = 0; rg < 16; ++rg) at[rg] = 0.f;
#pragma unroll
                    for (int kk = 0; kk < 8; ++kk) { const bf16x8 kf = *(const LAS bf16x8*)(L + HG_KG + 8192 * si + rx[kk]), qf = *(const LAS bf16x8*)(L + HG_QG + 8192 * tj + rx[kk]);
                        at = __builtin_amdgcn_mfma_f32_32x32x16_bf16(kf, qf, at, 0, 0, 0); if ((kk & 3) == 3) HG_SB(); }
                    if (si == tj) {
#pragma unroll
                        for (int rg = 0; rg < 16; ++rg) { const int sl = (rg & 3) + 8 * (rg >> 2) + 4 * hh; at[rg] = sl > r ? 0.f : at[rg]; }
                    }
#pragma unroll
                    for (int ks = 0; ks < 2; ++ks) { const bf16x8 af = pack8(at[8 * ks + 0], at[8 * ks + 1], at[8 * ks + 2], at[8 * ks + 3], at[8 * ks + 4], at[8 * ks + 5], at[8 * ks + 6], at[8 * ks + 7]);
                        o[tj] = __builtin_amdgcn_mfma_f32_32x32x16_bf16(vf[2 * si + ks], af, o[tj], 0, 0, 0); }
                    HG_SB();
                }
            }
#pragma unroll
            for (int dt = 0; dt < 4; ++dt) {
                f32x16 kv;
#pragma unroll
                for (int rg = 0; rg < 16; ++rg) kv[rg] = 0.f;
#pragma unroll
                for (int ks = 0; ks < 4; ++ks) { const bf16x8 kt = tr_pair(L + HG_KG + 4096 * ks + tk0[dt], L + HG_KG + 4096 * ks + tk1[dt]);
                    kv = __builtin_amdgcn_mfma_f32_32x32x16_bf16(kt, vf[ks], kv, 0, 0, 0); }
#pragma unroll
                for (int q8 = 0; q8 < 2; ++q8) { const int d0 = 32 * dt + 16 * q8 + 8 * hh;
                    const f32x4 ea = *(const LAS f32x4*)(V + 128 + d0), eb = *(const LAS f32x4*)(V + 128 + d0 + 4), ra_ = *(const LAS f32x4*)(V + 256 + d0), rb_ = *(const LAS f32x4*)(V + 256 + d0 + 4);
#pragma unroll
                    for (int e = 0; e < 4; ++e) { S[dt][8 * q8 + e] = ea[e] * S[dt][8 * q8 + e] + ra_[e] * kv[8 * q8 + e]; S[dt][8 * q8 + 4 + e] = eb[e] * S[dt][8 * q8 + 4 + e] + rb_[e] * kv[8 * q8 + 4 + e]; } }
                HG_SB();
            }
            if (FULL) {
                LAS float* SS = (LAS float*)(L + HG_SS);
                int gtC = gt; asm volatile("" : "+v"(gtC));
#pragma unroll
                for (int tt = 0; tt < 2; ++tt) { float ss = 0.f;
#pragma unroll
                    for (int rg = 0; rg < 16; ++rg) ss += o[tt][rg] * o[tt][rg];
                    ss += __shfl_xor(ss, 32);
                    SS[w * 64 + 32 * tt + r] = ss; }
                __syncthreads();
                int hwo = 32 * w + 4 * hh;
#pragma unroll
                for (int tt = 0; tt < 2; ++tt) { const int t = 32 * tt + r;
                    const float rstd = 1.f / sqrtf((SS[t] + SS[64 + t] + SS[128 + t] + SS[192 + t]) * (1.f / DH) + EPS);
#pragma unroll
                    for (int g4 = 0; g4 < 4; ++g4) { f32x4 x; const f32x4 hw4 = *(const f32x4*)(p.hnw + hwo + 8 * g4);
#pragma unroll
                        for (int e = 0; e < 4; ++e) x[e] = o[tt][4 * g4 + e] * rstd * hw4[e];
                        *(LAS f32x4*)(L + HG_OL + t * OL_PITCH + (32 * w + 8 * g4 + 4 * hh) * 4) = x; } }
                __syncthreads();
                const int ck = gtC & 15, cc = h * DH + 8 * ck;
                float cw0[8], cw1[8], cw2[8];
#pragma unroll
                for (int e = 0; e < 8; ++e) { cw0[e] = p.cw[cc + e]; cw1[e] = p.cw[D + cc + e]; cw2[e] = p.cw[2 * D + cc + e]; }
                const bf16* ga = (const bf16*)(p.ws + WS_GA); const bf16* bg = (const bf16*)(p.ws + WS_BG); const bf16* cx = (const bf16*)(p.ws + WS_CX); bf16* merged = (bf16*)(p.ws + WS_MERGED);
                bf16* dump = (bf16*)(p.ws + WS_DUMP); bf16* mergedm = (bf16*)(p.ws + WS_MERGEDM);
#pragma unroll
                for (int pass = 0; pass < 4; ++pass) {
                    HG_SB();
                    const int t = 16 * pass + ((gtC & 255) >> 4);
                    const int mrow = t >= 48 ? t - 48 : 0;
                    const int rr = metac ? M + mrow : rbase + t;
                    const int tok = metac ? mrow : (rr & (SEQ - 1));
                    const int r1 = tok >= 1 ? rr - 1 : M + NMETA - 1, r2 = tok >= 2 ? rr - 2 : M + NMETA - 2 + tok;
                    const unsigned m1 = (metac && tok < 1) ? 0u : 0xffffffffu, m2 = (metac && tok < 2) ? 0u : 0xffffffffu;
                    const f32x4 oa = *(const LAS f32x4*)(L + HG_OL + t * OL_PITCH + 32 * ck), ob = *(const LAS f32x4*)(L + HG_OL + t * OL_PITCH + 32 * ck + 16);
                    const u32x4 gv = *(const u32x4*)(ga + (size_t)rr * D + cc), bv = *(const u32x4*)(bg + (size_t)rr * D + cc), x0 = *(const u32x4*)(cx + (size_t)rr * D + cc);
                    const u32x4 x1 = *(const u32x4*)(cx + (size_t)r1 * D + cc) & m1, x2 = *(const u32x4*)(cx + (size_t)r2 * D + cc) & m2;
                    float res[8];
#pragma unroll
                    for (int e = 0; e < 8; ++e) { const unsigned gu = gv[e >> 1], bu = bv[e >> 1], u0_ = x0[e >> 1], u1_ = x1[e >> 1], u2_ = x2[e >> 1];
                        const float gaf = (e & 1) ? bfhi(gu) : bflo(gu), bgf = (e & 1) ? bfhi(bu) : bflo(bu), c0 = (e & 1) ? bfhi(u0_) : bflo(u0_), c1 = (e & 1) ? bfhi(u1_) : bflo(u1_), c2 = (e & 1) ? bfhi(u2_) : bflo(u2_);
                        const float on = e < 4 ? oa[e & 3] : ob[e & 3];
                        res[e] = on * gaf + bgf * (cw0[e] * c2 + cw1[e] * c1 + cw2[e] * c0); }
                    u32x4 wv; wv.x = cvtpk(res[0], res[1]); wv.y = cvtpk(res[2], res[3]); wv.z = cvtpk(res[4], res[5]); wv.w = cvtpk(res[6], res[7]);
                    const bool keep = !metac || (b == 0 && t >= 48);
                    bf16* dst = keep ? (metac ? mergedm + (size_t)mrow * D + cc : merged + (size_t)rr * D + cc) : dump + (gtC & 255) * 8;
                    *(u32x4*)dst = wv;
                }
            }
        }
        if (!FULL) {
#pragma unroll
            for (int dt = 0; dt < 4; ++dt)
#pragma unroll
                for (int rg = 0; rg < 16; ++rg) st[(size_t)slot * 16384 + ((w * 4 + dt) * 16 + rg) * 64 + lane] = S[dt][rg];
            if (w == 0) *(f32x2*)(gam + (size_t)slot * 128 + 2 * lane) = (f32x2){__expf(gt0), __expf(gt1)};
        }
        __syncthreads();
    }
}
__device__ __forceinline__ void hgrn_scan(const P& p, int gidx, int nthreads) {
    float* st = (float*)(p.ws + WS_ST); const float* gam = (const float*)(p.ws + WS_GAM);
    for (int task = gidx; task < 16 * 8192; task += nthreads) {
        const int bh = task >> 13, e2 = (task & 8191) * 2, ln = e2 & 63, rg = (e2 >> 6) & 15, dt = (e2 >> 10) & 3, d = 32 * dt + 16 * (rg >> 3) + 8 * (ln >> 5) + (rg & 7);
        float sx = 0.f, sy = 0.f;
#pragma unroll 4
        for (int seg = 0; seg < 31; ++seg) { const int slot = bh * 32 + seg; const float g = gam[(size_t)slot * 128 + d]; f32x2* sp = (f32x2*)(st + (size_t)slot * 16384 + e2);
            const f32x2 x = *sp; sx = g * sx + x.x; sy = g * sy + x.y; *sp = (f32x2){sx, sy}; }
    }
}
#define XB_TMO      128
#define XB_XCNT(j)  (256  + 64 * (j))
#define XB_XSUB(j)  (1280 + 64 * (j))
#define XB_XGEN(j)  (2304 + 64 * (j))
#define XB_TOP      3328
#define XB_TOPGEN   3392
#define XCD_BAR_WORDS 3456
#define XB_SPIN_CAP (1u << 18)

__device__ __forceinline__ unsigned xb_ld(unsigned* p)              { return __hip_atomic_load(p, __ATOMIC_RELAXED, __HIP_MEMORY_SCOPE_AGENT); }
__device__ __forceinline__ unsigned xb_add(unsigned* p, unsigned v) { return __hip_atomic_fetch_add(p, v, __ATOMIC_RELAXED, __HIP_MEMORY_SCOPE_AGENT); }
__device__ __forceinline__ unsigned xb_xcc_id() { return (unsigned)__builtin_amdgcn_s_getreg((3 << 11) | 20) & 0xFu; }
#define XB_SPIN(cond, bar) do { unsigned _sp = 0; while (cond) { __builtin_amdgcn_s_sleep(1); \
    if ((++_sp & 255u) == 0u) { if (xb_ld(&(bar)[XB_TMO])) break; if (_sp > XB_SPIN_CAP) { atomicAdd(&(bar)[XB_TMO], 1u); break; } } } } while (0)

struct XcdBarrier {
    unsigned* bar; unsigned x;
    volatile LAS unsigned* st;
};

__device__ __forceinline__ XcdBarrier xcd_barrier_post(unsigned* bar, volatile LAS unsigned* st) {
    XcdBarrier b; b.bar = bar; b.x = xb_xcc_id(); b.st = st;
    if (threadIdx.x == 0) (void)xb_add(&bar[XB_XCNT(b.x)], 1u);
    return b;
}
__device__ __forceinline__ void xcd_barrier_complete(unsigned* bar, unsigned x, unsigned& nloc, unsigned& nx) {
    const unsigned G = gridDim.x * gridDim.y * gridDim.z;
    unsigned sum, cnt, mine, sp = 0u;
    for (;;) {
        sum = 0u; cnt = 0u; mine = 0u;
#pragma unroll
        for (unsigned j = 0; j < 16; ++j) { const unsigned c = xb_ld(&bar[XB_XCNT(j)]); sum += c; cnt += (c > 0u) ? 1u : 0u; mine = (j == x) ? c : mine; }
        if (sum == G) break;
        __builtin_amdgcn_s_sleep(1);
        if ((++sp & 255u) == 0u) { if (xb_ld(&bar[XB_TMO])) break; if (sp > XB_SPIN_CAP) { atomicAdd(&bar[XB_TMO], 1u); break; } }
    }
    nloc = mine > 0u ? mine : 1u; nx = cnt > 0u ? cnt : 1u;
}

__device__ __forceinline__ void xcd_barrier(const XcdBarrier& b) {
    asm volatile("s_waitcnt vmcnt(0)" ::: "memory");
    __syncthreads();
    if (threadIdx.x == 0) {
        unsigned* bar = b.bar;
        __builtin_amdgcn_s_waitcnt(0);
        unsigned nloc = b.st[0], nx = b.st[1];
        if (nloc == 0u) { xcd_barrier_complete(bar, b.x, nloc, nx); b.st[0] = nloc; b.st[1] = nx; }
        const unsigned old = xb_add(&bar[XB_XSUB(b.x)], 1u);
        const unsigned gen = old / nloc;
        if (old + 1u == (gen + 1u) * nloc) {
            __builtin_amdgcn_fence(__ATOMIC_RELEASE, "agent");
            asm volatile("s_waitcnt vmcnt(0)" ::: "memory");
            const unsigned og = xb_add(&bar[XB_TOP], 1u);
            const unsigned tg = og / nx;
            if (og + 1u == (tg + 1u) * nx) xb_add(&bar[XB_TOPGEN], 1u);
            else XB_SPIN(xb_ld(&bar[XB_TOPGEN]) == tg, bar);
            __builtin_amdgcn_fence(__ATOMIC_ACQUIRE, "agent");
            xb_add(&bar[XB_XGEN(b.x)], 1u);
            asm volatile("s_waitcnt vmcnt(0)" ::: "memory");
        } else {
            XB_SPIN(xb_ld(&bar[XB_XGEN(b.x)]) == gen, bar);
            __builtin_amdgcn_fence(__ATOMIC_ACQUIRE, "agent");
            asm volatile("s_waitcnt vmcnt(0)" ::: "memory");
        }
    }
    __syncthreads();
}

struct Args { P p; int ph_lo, ph_hi; };
__global__ void __launch_bounds__(NWAVES * 64, 2) fwd_mega(Args args) {
    extern __shared__ __attribute__((aligned(16))) unsigned char lds_raw[];
    LAS unsigned char* lds = (LAS unsigned char*)lds_raw;
    volatile LAS unsigned* MISC = (volatile LAS unsigned*)(lds + MISC_OFF);
    const P& p = args.p;
    const int tid = threadIdx.x, lane = tid & 63, wave = __builtin_amdgcn_readfirstlane(tid >> 6);
    const int G = gridDim.x, bx = blockIdx.x, vcu = (G % 8 == 0) ? (bx % 8) * (G / 8) + bx / 8 : bx;
    const int gw = vcu * NWAVES + wave, NGW = G * NWAVES;
    gu32* ctl = (gu32*)(p.ws + WS_CTL);
    for (int u = tid; u < (LDS_BYTES - LDSCTL_OFF) / 4; u += NWAVES * 64) ((LAS unsigned*)(lds + LDSCTL_OFF))[u] = 0u;
    __syncthreads();
    XcdBarrier bar = xcd_barrier_post((unsigned*)(ctl + CW_BAR), MISC + 8);
    const int lo = args.ph_lo, hi = args.ph_hi;
#define IN(k) (lo <= (k) && (k) < hi)
#define SEAM(k) do { if (IN(k) && IN((k) + 1)) xcd_barrier(bar); } while (0)

    if (IN(0)) { p0_prologue(p, lds, vcu, G, wave, lane); }
    SEAM(0);
    if (IN(1)) {
        pg8::Gemm g{(const bf16*)(p.ws + WS_XB), (const bf16*)(p.ws + WS_WIN), M, NIN, D}; pg8::StaticOrder S; S.init(M, NIN, G, bx);
        Epi1 E{p.ws, p.out, (const float*)(p.ws + WS_LB)};
        pg8::gemm_phase<Epi1, pg8::StaticOrder, true, true>(lds, g, S, E);
        aux_meta_gemm1(p, gw, NGW, lane);
    }
    SEAM(1);
    if (IN(2)) { hgrn_units<false>(p, lds, bx, G, tid); }
    SEAM(2);
    if (IN(3)) { hgrn_scan(p, bx * (NWAVES * 64) + tid, G * NWAVES * 64); }
    SEAM(3);
    if (IN(4)) { hgrn_units<true>(p, lds, bx, G, tid); }
    SEAM(4);
    if (IN(5)) {
        const bf16* merged = (const bf16*)(p.ws + WS_MERGED);
        aux_meta_gemm2(p, (const bf16*)(p.ws + WS_MERGEDM), gw, NGW, lane);
        pg8::Gemm g{merged, (const bf16*)(p.ws + WS_WOUT), M, D, D}; pg8::StaticOrder S; S.init(M, D, G, bx);
        Epi2 E{p.x, p.out, (bf16*)(p.ws + WS_H1B), (float*)(p.ws + WS_RSS2)};
        pg8::gemm_phase<Epi2, pg8::StaticOrder, true, true>(lds, g, S, E);
    }
    SEAM(5);
    if (IN(6)) {
        pg8::Gemm g{(const bf16*)(p.ws + WS_H1B), (const bf16*)(p.ws + WS_WUP), 2 * G3_TILES_PER_BATCH * 256, NUP, D}; Sched3 S; S.init(2 * G3_TILES_PER_BATCH * 256, NUP, G, bx);
        Epi3 E{(bf16*)(p.ws + WS_G), (const float*)(p.ws + WS_RSS2), p.fcw, p.fcb, (LAS float*)(lds + XCH_OFF)};
        pg8::gemm_phase<Epi3, Sched3, true, true>(lds, g, S, E);
    }
    SEAM(6);
    if (IN(7)) {
        pg8::Gemm g{(const bf16*)(p.ws + WS_G), (const bf16*)(p.ws + WS_WDN), M, D, DFF}; pg8::StaticOrder S; S.init(M, D, G, bx);
        Epi4 E{p.out, (float*)(p.ws + WS_RSS3)};
        pg8::gemm_phase<Epi4, pg8::StaticOrder, true, true>(lds, g, S, E);
    }
    SEAM(7);
    if (IN(8)) { final_norm(p, gw, NGW, lane); }
#undef IN
#undef SEAM
}

constexpr int N_PHASES = 9;
#ifndef MK_N_LAUNCHES
#define MK_N_LAUNCHES 1
#endif
extern "C" void kernel_launch(void* const* d_in, const int* in_sizes, int n_in, void* d_out, int out_size, void* d_ws, size_t ws_size, hipStream_t stream) {
    static int grid = 0;
    if (grid == 0) {
        if (n_in != 14 || in_sizes[0] != M * D || out_size != M * D || ws_size < WS_END) { fprintf(stderr, "kernel_launch: unexpected shapes (n_in %d, in0 %d, out %d, ws %zu)\n", n_in, n_in > 0 ? in_sizes[0] : -1, out_size, ws_size); grid = -1; return; }
        int dev = 0, cus = 0, per_cu = 0;
        if (hipGetDevice(&dev) != hipSuccess || hipDeviceGetAttribute(&cus, hipDeviceAttributeMultiprocessorCount, dev) != hipSuccess) { grid = -1; return; }
        if (hipFuncSetAttribute((const void*)fwd_mega, hipFuncAttributeMaxDynamicSharedMemorySize, LDS_BYTES) != hipSuccess) { fprintf(stderr, "kernel_launch: hipFuncSetAttribute failed\n"); grid = -1; return; }
        if (hipOccupancyMaxActiveBlocksPerMultiprocessor(&per_cu, (const void*)fwd_mega, NWAVES * 64, LDS_BYTES) != hipSuccess || per_cu < 1) { fprintf(stderr, "kernel_launch: occupancy query says %d blocks per CU\n", per_cu); per_cu = 1; }
        (void)hipGetLastError();
        grid = cus;
    }
    if (grid < 0) return;
    if (hipMemsetAsync((char*)d_ws + WS_CTL, 0, CTL_ZERO_BYTES, stream) != hipSuccess) { fprintf(stderr, "kernel_launch: memset failed\n"); return; }
    Args a{};
    const float** f = (const float**)&a.p;
    for (int i = 0; i < 14; ++i) f[i] = (const float*)d_in[i];
    a.p.out = (float*)d_out; a.p.ws = (unsigned char*)d_ws;
    if (MK_N_LAUNCHES == 1) { a.ph_lo = 0; a.ph_hi = N_PHASES; hipLaunchKernelGGL(fwd_mega, dim3(grid), dim3(NWAVES * 64), LDS_BYTES, stream, a); }
    else for (int li = 0; li < N_PHASES; ++li) { a.ph_lo = li; a.ph_hi = li + 1; hipLaunchKernelGGL(fwd_mega, dim3(grid), dim3(NWAVES * 64), LDS_BYTES, stream, a); }
}
```
